# Optimizing an MI355X kernel written in HIP

```python
import math
import jax, jax.numpy as jnp
from jax import lax
import numpy as np

D_MODEL = 1024
BATCH = 8
SEQ = 4096
DEPTH = 1

N_MEM = 256
ROPE_THETA = 500000.0
Q_BLOCK = 128
NEG_INF = -1e30
LN_EPS = 1e-5
RMS_EPS = 1e-6

DIFF_HEADS = 4
DIFF_QK_DIM = 64
DIFF_V_DIM = 128
DIFF_ROT_DIM = DIFF_QK_DIM // 4
MLA_HEADS = 4
MLA_Q_RANK = 256
MLA_KV_RANK = 128
MLA_NOPE_DIM = 128
MLA_ROPE_DIM = 64
MLA_V_DIM = 128
MIX_WIDTH = DIFF_HEADS * DIFF_V_DIM + MLA_HEADS * MLA_V_DIM
DIFF_Q_COLS = DIFF_HEADS * 2 * DIFF_QK_DIM
DIFF_K_COLS = DIFF_HEADS * 2 * DIFF_QK_DIM
DIFF_V_COLS = DIFF_HEADS * DIFF_V_DIM
IN_COLS = DIFF_Q_COLS + DIFF_K_COLS + DIFF_V_COLS + MLA_Q_RANK + MLA_KV_RANK + MLA_ROPE_DIM
IN_SPLITS = (DIFF_Q_COLS,
             DIFF_Q_COLS + DIFF_K_COLS,
             DIFF_Q_COLS + DIFF_K_COLS + DIFF_V_COLS,
             DIFF_Q_COLS + DIFF_K_COLS + DIFF_V_COLS + MLA_Q_RANK,
             DIFF_Q_COLS + DIFF_K_COLS + DIFF_V_COLS + MLA_Q_RANK + MLA_KV_RANK)
MEM_HEADS = 4
MEM_HEAD_DIM = 128
N_EXPERTS = 64
TOP_K = 8
N_GROUPS = 8
TOPK_GROUPS = 4
EXPERT_DIM = 256
SHARED_DIM = 256
ROUTED_SCALE = 2.5
DEEPNORM_ALPHA = (2.0 * DEPTH) ** 0.25
DEEPNORM_BETA = (8.0 * DEPTH) ** -0.25

kernel_name = 'hybrid_diffattn_mla_moe_deepnorm'


def layer_norm(x, g, b):
    xf = x.astype(jnp.float32)
    mu = jnp.mean(xf, axis=-1, keepdims=True)
    var = jnp.mean(jnp.square(xf - mu), axis=-1, keepdims=True)
    return ((xf - mu) * lax.rsqrt(var + LN_EPS)).astype(x.dtype) * g + b


def rms_norm(x, g):
    xf = x.astype(jnp.float32)
    return (xf * lax.rsqrt(jnp.mean(jnp.square(xf), axis=-1, keepdims=True) + RMS_EPS)).astype(x.dtype) * g


def rope_tables(positions, dim):
    inv_freq = ROPE_THETA ** (-jnp.arange(0, dim, 2, dtype=jnp.float32) / dim)
    ang = positions.astype(jnp.float32)[..., None] * inv_freq
    return jnp.cos(ang)[:, :, None, :], jnp.sin(ang)[:, :, None, :]


def apply_rope(x, cos, sin):
    x1, x2 = jnp.split(x.astype(jnp.float32), 2, axis=-1)
    return jnp.concatenate([x1 * cos - x2 * sin, x2 * cos + x1 * sin], axis=-1).astype(x.dtype)


def partial_rope(x, cos, sin, rot_dim):
    return jnp.concatenate([apply_rope(x[..., :rot_dim], cos, sin), x[..., rot_dim:]], axis=-1)


def causal_attention(q, k, v, scale):
    B, S, H, Dk = q.shape
    Dv = v.shape[-1]
    nb = S // Q_BLOCK
    q_blocks = q.reshape(B, nb, Q_BLOCK, H, Dk).transpose(1, 0, 2, 3, 4)
    key_idx = jnp.arange(S)

    def one_block(args):
        qb, b_idx = args
        s = jnp.einsum('bqhd,bkhd->bhqk', qb, k, preferred_element_type=jnp.float32) * scale
        q_idx = b_idx * Q_BLOCK + jnp.arange(Q_BLOCK)
        s = jnp.where(key_idx[None, :] <= q_idx[:, None], s, NEG_INF)
        p = jax.nn.softmax(s, axis=-1).astype(v.dtype)
        return jnp.einsum('bhqk,bkhd->bqhd', p, v)

    out = lax.map(one_block, (q_blocks, jnp.arange(nb)))
    return out.transpose(1, 0, 2, 3, 4).reshape(B, S, H, Dv)


def hybrid_mixer(x, cos_d, sin_d, cos_m, sin_m, layer_idx, w_in, lam_q1, lam_k1, lam_q2, lam_k2,
                 diff_subln_g, mla_q_norm_g, mla_w_uq, mla_kv_norm_g, mla_w_ukv, mla_out_norm_g, w_o):
    B, S, _ = x.shape
    proj = jnp.einsum('bsd,dc->bsc', x, w_in)
    d_q, d_k, d_v, c_q, c_kv, k_rope = jnp.split(proj, IN_SPLITS, axis=-1)

    d_q = partial_rope(d_q.reshape(B, S, 2 * DIFF_HEADS, DIFF_QK_DIM), cos_d, sin_d, DIFF_ROT_DIM)
    d_k = partial_rope(d_k.reshape(B, S, 2 * DIFF_HEADS, DIFF_QK_DIM), cos_d, sin_d, DIFF_ROT_DIM)
    d_q = d_q.reshape(B, S, DIFF_HEADS, 2, DIFF_QK_DIM)
    d_k = d_k.reshape(B, S, DIFF_HEADS, 2, DIFF_QK_DIM)
    d_v = d_v.reshape(B, S, DIFF_HEADS, DIFF_V_DIM)
    lam_init = 0.8 - 0.6 * math.exp(-0.3 * layer_idx)
    lam = (jnp.exp(jnp.sum(lam_q1.astype(jnp.float32) * lam_k1.astype(jnp.float32)))
           - jnp.exp(jnp.sum(lam_q2.astype(jnp.float32) * lam_k2.astype(jnp.float32))) + lam_init)
    scale_d = DIFF_QK_DIM ** -0.5
    a1 = causal_attention(d_q[:, :, :, 0], d_k[:, :, :, 0], d_v, scale_d)
    a2 = causal_attention(d_q[:, :, :, 1], d_k[:, :, :, 1], d_v, scale_d)
    diff_out = rms_norm(a1 - lam.astype(a1.dtype) * a2, diff_subln_g) * (1.0 - lam_init)

    q = jnp.einsum('bsr,rc->bsc', rms_norm(c_q, mla_q_norm_g), mla_w_uq)
    q = q.reshape(B, S, MLA_HEADS, MLA_NOPE_DIM + MLA_ROPE_DIM)
    q_nope, q_pe = jnp.split(q, [MLA_NOPE_DIM], axis=-1)
    kv = jnp.einsum('bsr,rc->bsc', rms_norm(c_kv, mla_kv_norm_g), mla_w_ukv)
    kv = kv.reshape(B, S, MLA_HEADS, MLA_NOPE_DIM + MLA_V_DIM)
    k_nope, v_m = jnp.split(kv, [MLA_NOPE_DIM], axis=-1)
    k_pe = apply_rope(k_rope[:, :, None, :], cos_m, sin_m)
    q_m = jnp.concatenate([q_nope, apply_rope(q_pe, cos_m, sin_m)], axis=-1)
    k_m = jnp.concatenate([k_nope, jnp.broadcast_to(k_pe, (B, S, MLA_HEADS, MLA_ROPE_DIM))], axis=-1)
    mla_out = causal_attention(q_m, k_m, v_m, (MLA_NOPE_DIM + MLA_ROPE_DIM) ** -0.5)
    mla_out = rms_norm(mla_out, mla_out_norm_g)

    mixed = jnp.concatenate([diff_out.reshape(B, S, DIFF_HEADS * DIFF_V_DIM),
                             mla_out.reshape(B, S, MLA_HEADS * MLA_V_DIM)], axis=-1)
    return jnp.einsum('bsc,cd->bsd', mixed, w_o)


def memory_attention(x, mem, w_q, w_k, w_v, w_o):
    B, S, _ = x.shape
    q = jnp.einsum('bsd,dc->bsc', x, w_q).reshape(B, S, MEM_HEADS, MEM_HEAD_DIM)
    k = jnp.einsum('bmd,dc->bmc', mem, w_k).reshape(B, N_MEM, MEM_HEADS, MEM_HEAD_DIM)
    v = jnp.einsum('bmd,dc->bmc', mem, w_v).reshape(B, N_MEM, MEM_HEADS, MEM_HEAD_DIM)
    s = jnp.einsum('bshd,bmhd->bhsm', q, k, preferred_element_type=jnp.float32) * MEM_HEAD_DIM ** -0.5
    p = jax.nn.softmax(s, axis=-1).astype(v.dtype)
    o = jnp.einsum('bhsm,bmhd->bshd', p, v).reshape(B, S, MEM_HEADS * MEM_HEAD_DIM)
    return jnp.einsum('bsc,cd->bsd', o, w_o)


def moe_ffn(x, router_w, router_bias, w_gate, w_up, w_down, sh_gate, sh_up, sh_down):
    B, S, D = x.shape
    t = x.reshape(B * S, D)
    T = t.shape[0]
    scores = jax.nn.sigmoid(jnp.dot(t, router_w, preferred_element_type=jnp.float32))
    choice = scores + router_bias.astype(jnp.float32)
    group_score = lax.top_k(choice.reshape(T, N_GROUPS, N_EXPERTS // N_GROUPS), 2)[0].sum(-1)
    _, top_groups = lax.top_k(group_score, TOPK_GROUPS)
    group_mask = jnp.sum(jax.nn.one_hot(top_groups, N_GROUPS, dtype=jnp.float32), axis=1) > 0
    expert_mask = jnp.repeat(group_mask, N_EXPERTS // N_GROUPS, axis=-1)
    _, top_idx = lax.top_k(jnp.where(expert_mask, choice, NEG_INF), TOP_K)
    top_w = jnp.take_along_axis(scores, top_idx, axis=-1)
    top_w = top_w / jnp.sum(top_w, axis=-1, keepdims=True) * ROUTED_SCALE
    gates = jnp.zeros((T, N_EXPERTS), jnp.float32).at[jnp.arange(T)[:, None], top_idx].set(top_w)
    gates = gates.astype(t.dtype)
    out = jnp.dot(jax.nn.silu(t @ sh_gate) * (t @ sh_up), sh_down)
    for e in range(N_EXPERTS):
        h = jax.nn.silu(t @ w_gate[e]) * (t @ w_up[e])
        out = out + gates[:, e:e + 1] * (h @ w_down[e])
    return out.reshape(B, S, D)


def setup_inputs(seed: int = 0) -> dict:
    key = jax.random.key(seed)
    ks = iter(jax.random.split(key, 40))
    L = DEPTH

    def nrm(shape):
        return jax.random.normal(next(ks), shape, jnp.float32)

    def w(shape, fan_in, scale=1.0):
        return nrm(shape) * (scale * fan_in ** -0.5)

    def gain(shape):
        return 1.0 + 0.02 * nrm(shape)

    x = nrm((BATCH, SEQ, D_MODEL))
    mem = nrm((BATCH, N_MEM, D_MODEL))
    offset = jax.random.randint(next(ks), (BATCH, 1), 0, 1024, dtype=jnp.int32)
    positions = (offset + jnp.arange(SEQ, dtype=jnp.int32)[None, :]).astype(jnp.int32)
    return {
        'x': x,
        'mem': mem,
        'positions': positions,
        'w_in': w((L, D_MODEL, IN_COLS), D_MODEL),
        'lam_q1': 0.1 * nrm((L, DIFF_QK_DIM)),
        'lam_k1': 0.1 * nrm((L, DIFF_QK_DIM)),
        'lam_q2': 0.1 * nrm((L, DIFF_QK_DIM)),
        'lam_k2': 0.1 * nrm((L, DIFF_QK_DIM)),
        'diff_subln_g': gain((L, DIFF_V_DIM)),
        'mla_q_norm_g': gain((L, MLA_Q_RANK)),
        'mla_w_uq': w((L, MLA_Q_RANK, MLA_HEADS * (MLA_NOPE_DIM + MLA_ROPE_DIM)), MLA_Q_RANK),
        'mla_kv_norm_g': gain((L, MLA_KV_RANK)),
        'mla_w_ukv': w((L, MLA_KV_RANK, MLA_HEADS * (MLA_NOPE_DIM + MLA_V_DIM)), MLA_KV_RANK),
        'mla_out_norm_g': gain((L, MLA_V_DIM)),
        'w_o': w((L, MIX_WIDTH, D_MODEL), MIX_WIDTH, DEEPNORM_BETA),
        'ln1_g': gain((L, D_MODEL)),
        'ln1_b': 0.02 * nrm((L, D_MODEL)),
        'mem_w_q': w((L, D_MODEL, MEM_HEADS * MEM_HEAD_DIM), D_MODEL),
        'mem_w_k': w((L, D_MODEL, MEM_HEADS * MEM_HEAD_DIM), D_MODEL),
        'mem_w_v': w((L, D_MODEL, MEM_HEADS * MEM_HEAD_DIM), D_MODEL),
        'mem_w_o': w((L, MEM_HEADS * MEM_HEAD_DIM, D_MODEL), MEM_HEADS * MEM_HEAD_DIM, DEEPNORM_BETA),
        'ln2_g': gain((L, D_MODEL)),
        'ln2_b': 0.02 * nrm((L, D_MODEL)),
        'router_w': w((L, D_MODEL, N_EXPERTS), D_MODEL),
        'router_bias': 0.01 * nrm((L, N_EXPERTS)),
        'exp_w_gate': w((L, N_EXPERTS, D_MODEL, EXPERT_DIM), D_MODEL),
        'exp_w_up': w((L, N_EXPERTS, D_MODEL, EXPERT_DIM), D_MODEL),
        'exp_w_down': w((L, N_EXPERTS, EXPERT_DIM, D_MODEL), EXPERT_DIM, DEEPNORM_BETA),
        'sh_w_gate': w((L, D_MODEL, SHARED_DIM), D_MODEL),
        'sh_w_up': w((L, D_MODEL, SHARED_DIM), D_MODEL),
        'sh_w_down': w((L, SHARED_DIM, D_MODEL), SHARED_DIM, DEEPNORM_BETA),
        'ln3_g': gain((L, D_MODEL)),
        'ln3_b': 0.02 * nrm((L, D_MODEL)),
    }


def reference(x, mem, positions, w_in, lam_q1, lam_k1, lam_q2, lam_k2, diff_subln_g,
              mla_q_norm_g, mla_w_uq, mla_kv_norm_g, mla_w_ukv, mla_out_norm_g, w_o, ln1_g, ln1_b,
              mem_w_q, mem_w_k, mem_w_v, mem_w_o, ln2_g, ln2_b,
              router_w, router_bias, exp_w_gate, exp_w_up, exp_w_down,
              sh_w_gate, sh_w_up, sh_w_down, ln3_g, ln3_b):
    cos_d, sin_d = rope_tables(positions, DIFF_ROT_DIM)
    cos_m, sin_m = rope_tables(positions, MLA_ROPE_DIM)
    h = x
    for l in range(DEPTH):
        mix = hybrid_mixer(h, cos_d, sin_d, cos_m, sin_m, l, w_in[l], lam_q1[l], lam_k1[l], lam_q2[l],
                           lam_k2[l], diff_subln_g[l], mla_q_norm_g[l], mla_w_uq[l], mla_kv_norm_g[l],
                           mla_w_ukv[l], mla_out_norm_g[l], w_o[l])
        h = layer_norm(DEEPNORM_ALPHA * h + mix, ln1_g[l], ln1_b[l])
        xat = memory_attention(h, mem, mem_w_q[l], mem_w_k[l], mem_w_v[l], mem_w_o[l])
        h = layer_norm(DEEPNORM_ALPHA * h + xat, ln2_g[l], ln2_b[l])
        ffn = moe_ffn(h, router_w[l], router_bias[l], exp_w_gate[l], exp_w_up[l], exp_w_down[l],
                      sh_w_gate[l], sh_w_up[l], sh_w_down[l])
        h = layer_norm(DEEPNORM_ALPHA * h + ffn, ln3_g[l], ln3_b[l])
    return h
```

```cpp
#include <hip/hip_runtime.h>
#include <stdint.h>
#include <stdio.h>

typedef _Float16 h16;
typedef _Float16 h16x2 __attribute__((ext_vector_type(2)));
typedef _Float16 h16x4 __attribute__((ext_vector_type(4)));
typedef _Float16 h16x8 __attribute__((ext_vector_type(8)));
typedef float f32x2 __attribute__((ext_vector_type(2)));
typedef float f32x4 __attribute__((ext_vector_type(4)));
typedef float f32x8 __attribute__((ext_vector_type(8)));
typedef float f32x16 __attribute__((ext_vector_type(16)));

constexpr int NB = 8, SEQ = 4096, T = NB * SEQ, DM = 1024, NMEM = 256, TM = NB * NMEM;
constexpr int NPROJ = 2048;
constexpr int C_DQ = 0, C_DK = 512, C_DV = 1024, C_CQ = 1536, C_CKV = 1792, C_KR = 1920;
constexpr int NUP = 1792, KUP = 384;
constexpr int NE = 64, NE1 = 65, TOPK = 8, EDIM = 256, NSLOT = 8;
constexpr int NCHUNK = 2, TCH = T / NCHUNK;
constexpr int ROWS_CH = TCH * NSLOT + NE * 256;
constexpr float ALPHA = 1.189207115002721f;
constexpr float LN_EPS = 1e-5f, RMS_EPS = 1e-6f;
constexpr float LOG2E = 1.4426950408889634f;

constexpr size_t MiB = 1u << 20;
constexpr size_t WS_CTL = 0, WS_WIN = 1 * MiB, WS_WUP = 5 * MiB, WS_WO = 7 * MiB, WS_WMQ = 9 * MiB, WS_WMKV = 10 * MiB, WS_WMO = 12 * MiB,
                 WS_WGU = 13 * MiB, WS_WD = 78 * MiB, WS_LIST = 111 * MiB, WS_XH = 117 * MiB, WS_ROPE = 181 * MiB, WS_MEMH = 191 * MiB, WS_MKV = 195 * MiB,
                 WS_PROJ = 201 * MiB, WS_QKVM = 329 * MiB, WS_MIX = 441 * MiB;
constexpr size_t WS_TOP = 1 * MiB, WS_H2H = WS_XH, WS_Y1 = WS_PROJ, WS_H1H = WS_QKVM, WS_QX = 393 * MiB, WS_OX = 425 * MiB,
                 WS_HS = 181 * MiB, WS_Y = 253 * MiB, WS_SSH = 384 * MiB, WS_HSS = 493 * MiB, WS_END = 509 * MiB + 4096;
static_assert((size_t)ROWS_CH * EDIM * 2 <= WS_Y - WS_HS && (size_t)TCH * NSLOT * DM * 2 == 256 * MiB && (size_t)T * EDIM * 2 == 16 * MiB, "MoE buffers");
constexpr int CW_CNT = 0, CW_FILL = 512, CW_OFF = 1024, CW_AQ = 2048, CW_CQ = 3072;
constexpr size_t WS_BAR = 64 * 1024, WS_RW = 199 * MiB;

__device__ __forceinline__ int crow(int r, int hi) { return (r & 3) + 8 * (r >> 2) + 4 * hi; }
__device__ __forceinline__ int shxi(int i, int o) {
    switch (o) {
        case 1: return __builtin_amdgcn_ds_swizzle(i, 0x041f);
        case 2: return __builtin_amdgcn_ds_swizzle(i, 0x081f);
        case 4: return __builtin_amdgcn_ds_swizzle(i, 0x101f);
        case 8: return __builtin_amdgcn_ds_swizzle(i, 0x201f);
        default: return __builtin_amdgcn_ds_swizzle(i, 0x401f);
    }
}
__device__ __forceinline__ float shx(float v, int o) { return __int_as_float(shxi(__float_as_int(v), o)); }
__device__ __forceinline__ float half_sum(float v) { auto rr = __builtin_amdgcn_permlane32_swap(__float_as_uint(v), __float_as_uint(v), false, false); return __uint_as_float(rr[0]) + __uint_as_float(rr[1]); }
__device__ __forceinline__ float wave_sum(float v) {
    v = half_sum(v);
#pragma unroll
    for (int o = 16; o > 0; o >>= 1) v += shx(v, o);
    return v;
}


#define XB_TMO      128
#define XB_XCNT(j)  (256  + 64 * (j))
#define XB_XSUB(j)  (1280 + 64 * (j))
#define XB_XGEN(j)  (2304 + 64 * (j))
#define XB_TOP      3328
#define XB_TOPGEN   3392
#define XCD_BAR_WORDS 3456
#define XB_SPIN_CAP (1u << 18)
#define LAS __attribute__((address_space(3)))
constexpr int LDS_GDX = 163840 - 32;
constexpr int LDS_WTAB = 163840 - 512;
__device__ __forceinline__ int hw_slot() { return (int)(__builtin_amdgcn_s_getreg((6 - 1) << 11 | (0 << 6) | 4)); }
__device__ __forceinline__ int tid_fresh() { const int w = __builtin_amdgcn_readfirstlane(((const volatile LAS int*)LDS_WTAB)[hw_slot()]);
    unsigned z = 0u; asm volatile("" : "+v"(z));
    return w * 64 + (int)__builtin_amdgcn_mbcnt_hi(~0u, __builtin_amdgcn_mbcnt_lo(~0u, z)); }
__device__ __forceinline__ int gdx() { return __builtin_amdgcn_readfirstlane(*(volatile LAS const int*)LDS_GDX); }

__device__ __forceinline__ unsigned xb_ld(unsigned* p)              { return __hip_atomic_load(p, __ATOMIC_RELAXED, __HIP_MEMORY_SCOPE_AGENT); }
__device__ __forceinline__ unsigned xb_add(unsigned* p, unsigned v) { return __hip_atomic_fetch_add(p, v, __ATOMIC_RELAXED, __HIP_MEMORY_SCOPE_AGENT); }
__device__ __forceinline__ unsigned xb_xcc_id() { return (unsigned)__builtin_amdgcn_s_getreg((3 << 11) | 20) & 0xFu; }
#define XB_SPIN(cond, bar) do { unsigned _sp = 0; while (cond) { __builtin_amdgcn_s_sleep(1); \
    if ((++_sp & 255u) == 0u) { if (xb_ld(&(bar)[XB_TMO])) break; if (_sp > XB_SPIN_CAP) { atomicAdd(&(bar)[XB_TMO], 1u); break; } } } } while (0)

struct XcdBarrier {
    unsigned* bar; unsigned x;
    volatile LAS unsigned* st;
};
__device__ __forceinline__ XcdBarrier xcd_barrier_post(unsigned* bar, volatile LAS unsigned* st) {
    XcdBarrier b; b.bar = bar; b.x = xb_xcc_id(); b.st = st;
    if (tid_fresh() == 0) (void)xb_add(&bar[XB_XCNT(b.x)], 1u);
    return b;
}
__device__ __forceinline__ void xcd_barrier_complete(unsigned* bar, unsigned x, unsigned& nloc, unsigned& nx) {
    const unsigned G = (unsigned)gdx();
    unsigned sum, cnt, mine, sp = 0u;
    for (;;) {
        sum = 0u; cnt = 0u; mine = 0u;
#pragma unroll
        for (unsigned j = 0; j < 16; ++j) { const unsigned c = xb_ld(&bar[XB_XCNT(j)]); sum += c; cnt += (c > 0u) ? 1u : 0u; mine = (j == x) ? c : mine; }
        if (sum == G) break;
        __builtin_amdgcn_s_sleep(1);
        if ((++sp & 255u) == 0u) { if (xb_ld(&bar[XB_TMO])) break; if (sp > XB_SPIN_CAP) { atomicAdd(&bar[XB_TMO], 1u); break; } }
    }
    nloc = mine > 0u ? mine : 1u; nx = cnt > 0u ? cnt : 1u;
}
__device__ __forceinline__ void xcd_barrier(const XcdBarrier& b) {
    asm volatile("s_waitcnt vmcnt(0)" ::: "memory");
    __syncthreads();
    if (tid_fresh() == 0) {
        unsigned* bar = b.bar;
        __builtin_amdgcn_s_waitcnt(0);
        unsigned nloc = b.st[0], nx = b.st[1];
        if (nloc == 0u) { xcd_barrier_complete(bar, b.x, nloc, nx); b.st[0] = nloc; b.st[1] = nx; }
        const unsigned old = xb_add(&bar[XB_XSUB(b.x)], 1u);
        const unsigned gen = old / nloc;
        if (old + 1u == (gen + 1u) * nloc) {
            __builtin_amdgcn_fence(__ATOMIC_RELEASE, "agent");
            asm volatile("s_waitcnt vmcnt(0)" ::: "memory");
            const unsigned og = xb_add(&bar[XB_TOP], 1u);
            const unsigned tg = og / nx;
            if (og + 1u == (tg + 1u) * nx) xb_add(&bar[XB_TOPGEN], 1u);
            else XB_SPIN(xb_ld(&bar[XB_TOPGEN]) == tg, bar);
            __builtin_amdgcn_fence(__ATOMIC_ACQUIRE, "agent");
            xb_add(&bar[XB_XGEN(b.x)], 1u);
            asm volatile("s_waitcnt vmcnt(0)" ::: "memory");
        } else {
            XB_SPIN(xb_ld(&bar[XB_XGEN(b.x)]) == gen, bar);
            __builtin_amdgcn_fence(__ATOMIC_ACQUIRE, "agent");
            asm volatile("s_waitcnt vmcnt(0)" ::: "memory");
        }
    }
    __syncthreads();
}

struct Params { const float* in[33]; float* out; char* ws; };
constexpr int NTHR = 512, NWAVE = 8;
constexpr int LDS_BYTES = 163840;
constexpr int LDS_XB = LDS_BYTES - 16, LDS_PTAB = LDS_BYTES - 1024;

__device__ __forceinline__ int bid_fresh() { int t = blockIdx.x; asm volatile("" : "+s"(t)); return t; }

__device__ __forceinline__ void ph_cvt(const float* __restrict__ in, h16* __restrict__ out, long n8) {
    const long stride = gdx() * (long)NTHR;
    for (long i = bid_fresh() * (long)NTHR + tid_fresh(); i < n8; i += 4 * stride) {
        f32x8 xv[4];
#pragma unroll
        for (int u = 0; u < 4; ++u) if (i + u * stride < n8) xv[u] = __builtin_nontemporal_load((const f32x8*)(in + (i + u * stride) * 8));
#pragma unroll
        for (int u = 0; u < 4; ++u) if (i + u * stride < n8) { h16x8 y;
#pragma unroll
            for (int j = 0; j < 8; ++j) y[j] = (h16)xv[u][j];
            *(h16x8*)(out + (i + u * stride) * 8) = y; }
    }
}
template <int MODE, int PF = 4, int KC = 0, int NC = 0, bool KG = false>
__device__ __forceinline__ void ph_tcvt(float* tile  , const float* __restrict__ in, int K_, int N_, int nz, h16* __restrict__ out, int ldo, int koff, int roff, long zstride,
                                        int tbeg = 0, int tend = -1, int rank = -2, int nrank = 0, const float* __restrict__ kgain = nullptr) {
    const int K = KC ? KC : K_, N = NC ? NC : N_;
    const int tid = tid_fresh(); const int lk = tid >> 4, ln4 = (tid & 15) * 4, sn = tid >> 3, sk8 = (tid & 7) * 8;
    const int nk = K / 64, nn_ = N / 64; const int ntile = tend < 0 ? nk * nn_ * nz : tend; const int G = rank == -2 ? gdx() : nrank; const int first = rank == -2 ? bid_fresh() : (rank < 0 ? ntile : tbeg + rank); int buf = 0;
    f32x4 r0[PF], r1[PF];
#define TC_LOAD(slot, itx) do { const int it_ = (itx); if (it_ < ntile) { const int z_ = it_ / (nk * nn_), rem_ = it_ % (nk * nn_), k0_ = (rem_ % nk) * 64, n0_ = (rem_ / nk) * 64; \
        const float* p_ = in + (size_t)z_ * K * N + (size_t)(k0_ + lk) * N + n0_ + ln4; r0[slot] = __builtin_nontemporal_load((const f32x4*)p_); r1[slot] = __builtin_nontemporal_load((const f32x4*)(p_ + (size_t)32 * N)); } } while (0)
#pragma unroll
    for (int j = 0; j < PF; ++j) TC_LOAD(j, first + j * G);
    for (int it = first; it < ntile; it += PF * G) {
#pragma unroll
        for (int j = 0; j < PF; ++j) {
            const int itj = it + j * G;
            if (itj < ntile) {
                const int z = itj / (nk * nn_), rem = itj % (nk * nn_), k0 = (rem % nk) * 64, n0 = (rem / nk) * 64;
                h16* outz = out + (size_t)z * zstride; float* tb = tile + buf * (64 * 68);
                *(f32x4*)(tb + lk * 68 + (ln4 ^ (((lk >> 3) & 7) << 2))) = r0[j]; *(f32x4*)(tb + (lk + 32) * 68 + (ln4 ^ ((((lk >> 3) + 4) & 7) << 2))) = r1[j];
                TC_LOAD(j, itj + PF * G);
                __syncthreads();
                h16x8 o;
#pragma unroll
                for (int i = 0; i < 8; ++i) o[i] = (h16)(tb[(sk8 + i) * 68 + (sn ^ ((tid & 7) << 2))] * (KG ? kgain[k0 + sk8 + i] : 1.f));
                const int n = n0 + sn; int r;
                if (MODE == 0) r = n + roff;
                else if (MODE == 4) { const int d = n & 63; r = (n < 1024 && d < 16) ? (n & ~63) + 8 * ((d >> 2) & 1) + 4 * (d >> 3) + (d & 3) : n; }
                else if (MODE == 3) { const int ol = n & 255; r = (n >> 8) * 256 + ((ol >> 3) & 1) * 128 + (ol >> 6) * 32 + ((ol >> 2) & 1) * 16 + ((ol >> 4) & 3) * 4 + (ol & 3) + roff; } else { const int hh = n & 127; r = (n >> 7) * 256 + ((hh >> 2) & 1) * 128 + (hh >> 5) * 32 + (MODE == 2 ? 16 : 0) + ((hh >> 3) & 3) * 4 + (hh & 3) + roff; }
                *(h16x8*)(outz + (size_t)r * ldo + koff + k0 + sk8) = o;
                buf ^= 1;
            }
        }
    }
#undef TC_LOAD
    __syncthreads();
}
__device__ __forceinline__ void ph_rope_tables(const int* __restrict__ pos, float* __restrict__ rope) {
    for (int i = bid_fresh() * NTHR + tid_fresh(); i < T * 40; i += gdx() * NTHR) {
        const int t = i / 40, j = i % 40; const float p = (float)pos[t];
        const double ex = (j < 8) ? (double)(2 * j) / 16.0 : (double)(2 * (j - 8)) / 64.0;
        const float invf = (float)exp2(-ex * 18.931568569324174);
        float sn, cs; sincosf(p * invf, &sn, &cs);
        if (j < 8) { rope[(size_t)t * 8 + j] = cs; rope[(size_t)T * 8 + (size_t)t * 8 + j] = sn; }
        else { const int jj = j - 8; rope[(size_t)T * 16 + (size_t)t * 32 + jj] = cs; rope[(size_t)T * 16 + (size_t)T * 32 + (size_t)t * 32 + jj] = sn; }
    }
}
__device__ __forceinline__ void ph_list_init(int* __restrict__ rowtok, int* __restrict__ rowdst, float* __restrict__ roww) {
    for (int i = bid_fresh() * NTHR + tid_fresh(); i < NCHUNK * ROWS_CH; i += gdx() * NTHR) { rowtok[i] = -1; rowdst[i] = TCH * NSLOT; roww[i] = 0.f; }
}

__device__ __forceinline__ void ph_postproj(h16* __restrict__ P, const float* __restrict__ rope, const float* __restrict__ gq, const float* __restrict__ gkv, int rank, int nrank) {
    const int lane = tid_fresh() & 63, l16 = lane & 15;
    for (int t = rank < 0 ? T : (rank * NWAVE + (tid_fresh() >> 6)) * 4 + (lane >> 4); t < T; t += nrank * NWAVE * 4) {
        h16* row = P + (size_t)t * NPROJ;
        const float* cd = rope + (size_t)t * 8; const float* cm = rope + (size_t)T * 16 + (size_t)t * 32; const float* sm = cm + (size_t)T * 32;
        h16* kp = row + C_DK + (l16 & 7) * 64 + (l16 >> 3) * 8;
        h16x8 ka = *(const h16x8*)kp; const f32x4 kc4 = *(const f32x4*)(cd + 4 * (l16 >> 3)), ks4 = *(const f32x4*)(cd + (size_t)T * 8 + 4 * (l16 >> 3));
        h16x8 q0 = *(const h16x8*)(row + C_CQ + l16 * 16), q1 = *(const h16x8*)(row + C_CQ + l16 * 16 + 8);
        h16x8 kv = *(const h16x8*)(row + C_CKV + l16 * 8);
        h16x4 kr = *(const h16x4*)(row + C_KR + l16 * 4);
        const f32x4 cm4 = *(const f32x4*)(cm + (l16 & 7) * 4), sm4 = *(const f32x4*)(sm + (l16 & 7) * 4);
        const f32x8 gq0 = *(const f32x8*)(gq + l16 * 16), gq1 = *(const f32x8*)(gq + l16 * 16 + 8), gk = *(const f32x8*)(gkv + l16 * 8);
#pragma unroll
        for (int j = 0; j < 4; ++j) { const float x1 = (float)ka[j], x2 = (float)ka[4 + j]; ka[j] = (h16)(x1 * kc4[j] - x2 * ks4[j]); ka[4 + j] = (h16)(x2 * kc4[j] + x1 * ks4[j]); }
        *(h16x8*)kp = ka;
        float fq[16], ssq = 0.f, fk[8], ssk = 0.f;
#pragma unroll
        for (int i = 0; i < 8; ++i) { fq[i] = (float)q0[i]; fq[8 + i] = (float)q1[i]; fk[i] = (float)kv[i]; ssq += fq[i] * fq[i] + fq[8 + i] * fq[8 + i]; ssk += fk[i] * fk[i]; }
#pragma unroll
        for (int o = 1; o < 16; o <<= 1) { ssq += shx(ssq, o); ssk += shx(ssk, o); }
        const float rq = rsqrtf(ssq * (1.f / 256.f) + RMS_EPS), rk = rsqrtf(ssk * (1.f / 128.f) + RMS_EPS);
#pragma unroll
        for (int i = 0; i < 8; ++i) { q0[i] = (h16)(fq[i] * rq * gq0[i]); q1[i] = (h16)(fq[8 + i] * rq * gq1[i]); kv[i] = (h16)(fk[i] * rk * gk[i]); }
        *(h16x8*)(row + C_CQ + l16 * 16) = q0; *(h16x8*)(row + C_CQ + l16 * 16 + 8) = q1; *(h16x8*)(row + C_CKV + l16 * 8) = kv;
#pragma unroll
        for (int j = 0; j < 4; ++j) { const float mine = (float)kr[j]; const float other = shx(mine, 8);
            const float x1 = (l16 < 8) ? mine : other, x2 = (l16 < 8) ? other : mine;
            kr[j] = (h16)((l16 < 8) ? (x1 * cm4[j] - x2 * sm4[j]) : (x2 * cm4[j] + x1 * sm4[j])); }
        *(h16x4*)(row + C_KR + l16 * 4) = kr;
    }
}
template <int NR>
__device__ __forceinline__ void ln_rows(h16* H, const float* __restrict__ g, const float* __restrict__ bta, int t, int lane) {
    h16x8 x[NR][2]; f32x8 v[NR][2]; float s[NR];
#pragma unroll
    for (int r = 0; r < NR; ++r) {
#pragma unroll
        for (int i = 0; i < 2; ++i) x[r][i] = *(const h16x8*)(H + (size_t)(t + r) * DM + i * 512 + lane * 8); }
#pragma unroll
    for (int r = 0; r < NR; ++r) { s[r] = 0.f;
#pragma unroll
        for (int i = 0; i < 2; ++i)
#pragma unroll
            for (int e = 0; e < 8; ++e) { v[r][i][e] = (float)x[r][i][e]; s[r] += v[r][i][e]; } }
#pragma unroll
    for (int r = 0; r < NR; ++r) s[r] = half_sum(s[r]);
#pragma unroll
    for (int o = 16; o > 0; o >>= 1) {
#pragma unroll
        for (int r = 0; r < NR; ++r) s[r] += shx(s[r], o); }
    float q[NR];
#pragma unroll
    for (int r = 0; r < NR; ++r) { const float mu = s[r] * (1.f / DM); q[r] = 0.f;
#pragma unroll
        for (int i = 0; i < 2; ++i)
#pragma unroll
            for (int e = 0; e < 8; ++e) { v[r][i][e] -= mu; q[r] += v[r][i][e] * v[r][i][e]; } }
#pragma unroll
    for (int r = 0; r < NR; ++r) q[r] = half_sum(q[r]);
#pragma unroll
    for (int o = 16; o > 0; o >>= 1) {
#pragma unroll
        for (int r = 0; r < NR; ++r) q[r] += shx(q[r], o); }
#pragma unroll
    for (int i = 0; i < 2; ++i) { const int c = i * 512 + lane * 8; const f32x8 gg = *(const f32x8*)(g + c), bb = *(const f32x8*)(bta + c);
#pragma unroll
        for (int r = 0; r < NR; ++r) { const float rs = rsqrtf(q[r] * (1.f / DM) + LN_EPS); h16x8 o;
#pragma unroll
            for (int e = 0; e < 8; ++e) o[e] = (h16)(v[r][i][e] * rs * gg[e] + bb[e]);
            *(h16x8*)(H + (size_t)(t + r) * DM + c) = o; } }
}
__device__ __forceinline__ void ph_lnfold(const h16* __restrict__ WmqTp, const float* __restrict__ Wmq, const float* __restrict__ b1, float* __restrict__ csbw) {
    const int lane = tid_fresh() & 63;
    for (int n = bid_fresh() * NWAVE + (tid_fresh() >> 6); n < 512; n += gdx() * NWAVE) {
        const h16x8 w0 = *(const h16x8*)(WmqTp + (size_t)n * 1024 + lane * 16), w1 = *(const h16x8*)(WmqTp + (size_t)n * 1024 + lane * 16 + 8);
        float c = 0.f, b = 0.f;
#pragma unroll
        for (int i = 0; i < 8; ++i) c += (float)w0[i] + (float)w1[i];
#pragma unroll
        for (int i = 0; i < 16; ++i) { const int k = lane * 16 + i; b += b1[k] * Wmq[(size_t)k * 512 + n]; }
        c = wave_sum(c); b = wave_sum(b);
        if (lane == 0) { csbw[n] = c; csbw[512 + n] = b; }
    }
}
__device__ __forceinline__ void ph_ln(h16* H, const float* __restrict__ g, const float* __restrict__ bta) {
    const int lane = tid_fresh() & 63;
    for (int t = (bid_fresh() * NWAVE + (tid_fresh() >> 6)) * 4; t < T; t += gdx() * NWAVE * 4) ln_rows<4>(H, g, bta, t, lane);
}
__device__ __forceinline__ void ph_router(char* lds, h16* H2hp, const float* __restrict__ lng, const float* __restrict__ lnb, const h16* __restrict__ rwh, const h16* __restrict__ rwl, const float* __restrict__ rb, int* __restrict__ topi, float* __restrict__ topw, int* __restrict__ ctlp) {
    constexpr int BST = 68, BSH = 72;
    const int tid = tid_fresh(), wv = tid >> 6, lane = tid & 63, j16 = lane & 15, kq = lane >> 4;
    h16* Bl = (h16*)lds;
    float* Lg = (float*)(lds + 2 * 2 * 64 * BSH * 2) + wv * (16 * BST);
    int* lcnt = (int*)(lds + 2 * 2 * 64 * BSH * 2 + NWAVE * 16 * BST * 4);
    for (int t0 = bid_fresh() * 128; t0 < T; t0 += gdx() * 128) {
        for (int rr = 0; rr < 16; rr += 4) ln_rows<4>(H2hp, lng, lnb, t0 + wv * 16 + rr, lane);
        asm volatile("s_waitcnt vmcnt(0)" ::: "memory");
        __syncthreads();
        if (tid < 64) lcnt[tid] = 0;
        const h16* xrow = H2hp + (size_t)(t0 + wv * 16 + j16) * DM + 8 * kq;
        f32x4 acc[4];
#pragma unroll
        for (int nb = 0; nb < 4; ++nb) acc[nb] = (f32x4){0.f, 0.f, 0.f, 0.f};
        const int se = (tid >> 2) & 63, sseg = (tid & 3) * 16; const h16* wsrc = (tid < 256 ? rwh : rwl) + (size_t)se * DM + sseg;
        h16* Bw = Bl + (tid >> 8) * (64 * BSH) + se * BSH + sseg;
        h16x8 breg[2];
        breg[0] = *(const h16x8*)wsrc; breg[1] = *(const h16x8*)(wsrc + 8);
        *(h16x8*)Bw = breg[0]; *(h16x8*)(Bw + 8) = breg[1];
        h16x8 a0n = *(const h16x8*)xrow, a1n = *(const h16x8*)(xrow + 32);
        __syncthreads();
        for (int c = 0; c < 16; ++c) {
            const h16* Bc = Bl + (c & 1) * (2 * 64 * BSH);
            if (c + 1 < 16) { breg[0] = *(const h16x8*)(wsrc + (c + 1) * 64); breg[1] = *(const h16x8*)(wsrc + (c + 1) * 64 + 8); }
            const h16x8 a0 = a0n, a1 = a1n;
            if (c + 1 < 16) { a0n = *(const h16x8*)(xrow + (c + 1) * 64); a1n = *(const h16x8*)(xrow + (c + 1) * 64 + 32); }
#pragma unroll
            for (int nb = 0; nb < 4; ++nb) { const h16* bp = Bc + (16 * nb + j16) * BSH + 8 * kq;
                acc[nb] = __builtin_amdgcn_mfma_f32_16x16x32_f16(a0, *(const h16x8*)bp, acc[nb], 0, 0, 0);
                acc[nb] = __builtin_amdgcn_mfma_f32_16x16x32_f16(a0, *(const h16x8*)(bp + 64 * BSH), acc[nb], 0, 0, 0);
                acc[nb] = __builtin_amdgcn_mfma_f32_16x16x32_f16(a1, *(const h16x8*)(bp + 32), acc[nb], 0, 0, 0);
                acc[nb] = __builtin_amdgcn_mfma_f32_16x16x32_f16(a1, *(const h16x8*)(bp + 64 * BSH + 32), acc[nb], 0, 0, 0); }
            if (c + 1 < 16) { h16* Bn = Bw + ((c + 1) & 1) * (2 * 64 * BSH); *(h16x8*)Bn = breg[0]; *(h16x8*)(Bn + 8) = breg[1]; }
            __syncthreads();
        }
#pragma unroll
        for (int nb = 0; nb < 4; ++nb) acc[nb] *= (1.f / 1024.f);
#pragma unroll
        for (int nb = 0; nb < 4; ++nb)
#pragma unroll
            for (int r = 0; r < 4; ++r) Lg[(4 * kq + r) * BST + 16 * nb + j16] = acc[nb][r];
        asm volatile("s_waitcnt lgkmcnt(0)" ::: "memory");
        const int tt = lane >> 2, part = lane & 3; const int t = t0 + wv * 16 + tt;
        float sc[16], ch[16];
#pragma unroll
        for (int q = 0; q < 4; ++q) { const f32x4 lg = *(const f32x4*)(Lg + tt * BST + 16 * part + 4 * q); const f32x4 bb = *(const f32x4*)(rb + 16 * part + 4 * q);
#pragma unroll
            for (int e = 0; e < 4; ++e) { const float sg = 1.f / (1.f + expf(-lg[e])); sc[4 * q + e] = sg; ch[4 * q + e] = sg + bb[e]; } }
        float gsl[2];
#pragma unroll
        for (int g = 0; g < 2; ++g) { float m1 = -1e30f, m2 = -1e30f;
#pragma unroll
            for (int e = 0; e < 8; ++e) { const float v = ch[g * 8 + e]; if (v > m1) { m2 = m1; m1 = v; } else if (v > m2) m2 = v; }
            gsl[g] = m1 + m2; }
        float gs[8];
#pragma unroll
        for (int pp = 0; pp < 4; ++pp) { gs[2 * pp] = __shfl(gsl[0], (lane & ~3) | pp); gs[2 * pp + 1] = __shfl(gsl[1], (lane & ~3) | pp); }
        unsigned gmask = 0;
#pragma unroll
        for (int it = 0; it < 4; ++it) { float best = -3e38f; int bi = 0;
#pragma unroll
            for (int g = 0; g < 8; ++g) if (!((gmask >> g) & 1) && gs[g] > best) { best = gs[g]; bi = g; }
            gmask |= 1u << bi; }
#pragma unroll
        for (int e = 0; e < 16; ++e) if (!((gmask >> (2 * part + (e >> 3))) & 1)) ch[e] = -1e30f;
        float wsel[8]; int isel[8]; float wsum = 0.f;
#pragma unroll
        for (int it = 0; it < 8; ++it) {
            float bv = -3e38f; int be = 0; float bs = 0.f;
#pragma unroll
            for (int e = 0; e < 16; ++e) if (ch[e] > bv) { bv = ch[e]; be = e; bs = sc[e]; }
            int bidx = 16 * part + be;
#pragma unroll
            for (int o = 1; o < 4; o <<= 1) { const float ov = shx(bv, o); const int oi = shxi(bidx, o); const float os = shx(bs, o);
                if (ov > bv || (ov == bv && oi < bidx)) { bv = ov; bidx = oi; bs = os; } }
#pragma unroll
            for (int e = 0; e < 16; ++e) if (bidx == 16 * part + e) ch[e] = -3e38f;
            wsel[it] = bs; isel[it] = bidx; wsum += bs;
        }
        const float inv = 2.5f / wsum;
#pragma unroll
        for (int it = 0; it < 8; ++it) if ((it >> 1) == part) { topi[(size_t)t * 8 + it] = isel[it]; topw[(size_t)t * 8 + it] = wsel[it] * inv; atomicAdd(&lcnt[isel[it]], 1); }
        __syncthreads();
        if (tid < 64) { const int n = lcnt[tid]; if (n) atomicAdd(&ctlp[CW_CNT + (t0 / TCH) * 64 + tid], n); }
    }
}
__device__ __forceinline__ void ph_offsets(int* loff  , int* __restrict__ ctlp) {
    __syncthreads();
    if (tid_fresh() < NCHUNK) { const int c = tid_fresh(); int o = 0;
        for (int e = 0; e < NE; ++e) { loff[c * 66 + e] = o; o += (__hip_atomic_load(&ctlp[CW_CNT + c * 64 + e], __ATOMIC_RELAXED, __HIP_MEMORY_SCOPE_AGENT) + 255) & ~255; }
        loff[c * 66 + 64] = o; loff[c * 66 + 65] = o; }
    __syncthreads();
    if (bid_fresh() == 0 && tid_fresh() < NCHUNK * 66) ctlp[CW_OFF + tid_fresh()] = loff[tid_fresh()];
}
__device__ __forceinline__ void ph_fill(int* loff, const int* __restrict__ topi, const float* __restrict__ topw, int* __restrict__ ctlp, int* __restrict__ rowtok, int* __restrict__ rowdst, float* __restrict__ roww) {
    int* lc = loff + NCHUNK * 66; int* lbase = lc + 64;
    const int tid = tid_fresh();
    for (int t0 = bid_fresh() * 128; t0 < T; t0 += gdx() * 128) {
        const int c = t0 / TCH;
        __syncthreads();
        if (tid < 64) lc[tid] = 0;
        __syncthreads();
        int e0 = 0, e1 = 0; float w0 = 0.f, w1 = 0.f;
        const int t = t0 + (tid >> 2), s0 = (tid & 3) * 2;
        { e0 = topi[(size_t)t * 8 + s0]; e1 = topi[(size_t)t * 8 + s0 + 1]; w0 = topw[(size_t)t * 8 + s0]; w1 = topw[(size_t)t * 8 + s0 + 1]; }
        atomicAdd(&lc[e0], 1); atomicAdd(&lc[e1], 1);
        __syncthreads();
        if (tid < 64) { const int n = lc[tid]; lbase[tid] = loff[c * 66 + tid] + (n ? atomicAdd(&ctlp[CW_FILL + c * 64 + tid], n) : 0); lc[tid] = 0; }
        __syncthreads();
        const int p0 = lbase[e0] + atomicAdd(&lc[e0], 1), p1 = lbase[e1] + atomicAdd(&lc[e1], 1);
        const int tl = t % TCH; const size_t o0 = (size_t)c * ROWS_CH + p0, o1 = (size_t)c * ROWS_CH + p1;
        rowtok[o0] = t; rowdst[o0] = tl * NSLOT + s0; roww[o0] = w0;
        rowtok[o1] = t; rowdst[o1] = tl * NSLOT + s0 + 1; roww[o1] = w1;
        }
}
__device__ __forceinline__ void cb_range(int r, int& tb, int& tn) {
    constexpr int DELTA = 64;
    const int G = gdx(), c = bid_fresh(), nl = r ? G - r : 0;
    int de = nl ? (TCH / nl < DELTA ? TCH / nl : DELTA) : 0;
    const int base = (TCH - nl * de) / G, rem = TCH - nl * de - base * G;
    const int cl0 = c > r ? c - r : 0, cl1 = c + 1 > r ? c + 1 - r : 0;
    const int s0 = c * base + (r ? cl0 * de : 0) + (c < rem ? c : rem), s1 = (c + 1) * base + (r ? cl1 * de : 0) + (c + 1 < rem ? c + 1 : rem);
    tb = s0; tn = s1 - s0;
}
__device__ __forceinline__ void ph_combine(const unsigned char* __restrict__ Y8, const h16* __restrict__ Sp, float* __restrict__ HO, int t0, const float* __restrict__ g, const float* __restrict__ bta, int tb, int tn) {
    typedef unsigned u32x4_ __attribute__((ext_vector_type(4)));
    const int lane = tid_fresh() & 63, wv_ = tid_fresh() >> 6;
    for (int tl = tb + wv_; tl < tb + tn; tl += NWAVE) {
        const int t = t0 + tl; float* h = HO + (size_t)t * DM + lane * 16;
        u32x4_ y[NSLOT];
#pragma unroll
        for (int sl = 0; sl < NSLOT; ++sl) y[sl] = *(const u32x4_*)(Y8 + ((size_t)tl * NSLOT + sl) * DM + lane * 16);
        f32x4 v[4]; { const h16x8 s0 = *(const h16x8*)(Sp + (size_t)t * DM + lane * 16), s1 = *(const h16x8*)(Sp + (size_t)t * DM + lane * 16 + 8);
            v[0] = (f32x4){(float)s0[0], (float)s0[1], (float)s0[2], (float)s0[3]}; v[1] = (f32x4){(float)s0[4], (float)s0[5], (float)s0[6], (float)s0[7]};
            v[2] = (f32x4){(float)s1[0], (float)s1[1], (float)s1[2], (float)s1[3]}; v[3] = (f32x4){(float)s1[4], (float)s1[5], (float)s1[6], (float)s1[7]}; }
        f32x4 a[4];
#pragma unroll
        for (int i = 0; i < 4; ++i) a[i] = (f32x4){0.f, 0.f, 0.f, 0.f};
#pragma unroll
        for (int sl = 0; sl < NSLOT; ++sl)
#pragma unroll
            for (int i = 0; i < 4; ++i) { const f32x2 lo = __builtin_amdgcn_cvt_pk_f32_fp8((int)y[sl][i], false), hi = __builtin_amdgcn_cvt_pk_f32_fp8((int)y[sl][i], true);
                a[i][0] += lo[0]; a[i][1] += lo[1]; a[i][2] += hi[0]; a[i][3] += hi[1]; }
        float s = 0.f;
#pragma unroll
        for (int i = 0; i < 4; ++i) { v[i] += a[i] * (1.f / 16.f); s += (v[i][0] + v[i][1]) + (v[i][2] + v[i][3]); }
        const float mu = wave_sum(s) * (1.f / DM); float q = 0.f;
#pragma unroll
        for (int i = 0; i < 4; ++i) { v[i] -= mu; q += (v[i][0] * v[i][0] + v[i][1] * v[i][1]) + (v[i][2] * v[i][2] + v[i][3] * v[i][3]); }
        const float rs = rsqrtf(wave_sum(q) * (1.f / DM) + LN_EPS);
#pragma unroll
        for (int i = 0; i < 4; ++i) { const int c = lane * 16 + 4 * i; *(f32x4*)(h + 4 * i) = v[i] * rs * *(const f32x4*)(g + c) + *(const f32x4*)(bta + c); }
    }
}

namespace g8 {
constexpr int BM = 256, BK = 64, HALF = 128, HTB = HALF * BK * 2, STAGE_BYTES = 8 * HTB, NXCD = 8, WGM = 8;
__host__ __device__ __forceinline__ int lds_byte(int r, int c) { const int st = (r >> 4) * 2 + (c >> 5), rr = r & 15, cc = c & 31, ob = rr * 64 + cc * 2; return st * 1024 + (ob ^ (((ob >> 9) & 1) << 5)); }
__host__ __device__ __forceinline__ void stage_rc(int b, int& R, int& C) { const int st = b / 1024, sb = b % 1024, swz = sb ^ (((sb >> 9) & 1) << 5); R = (st >> 1) * 16 + swz / 64; C = (st & 1) * 32 + (swz % 64) / 2; }
__host__ __device__ __forceinline__ int perm32(int rho) { const int n = rho >> 4, i = rho & 15; return 8 * (i >> 2) + 4 * n + (i & 3); }
struct Unit { const char* a; const char* b; const int* rows; int pm, pn, e, pad; };
struct DenseOrder {
    const char* A; const char* Bt; int lda, ldb, nM, nN, nwg, G, c;
    __device__ __forceinline__ void init(const h16* A_, int lda_, const h16* Bt_, int ldb_, int M, int N) { A = (const char*)A_; Bt = (const char*)Bt_; lda = lda_; ldb = ldb_; nM = M / BM; nN = N / BM; nwg = nM * nN; G = gdx(); c = bid_fresh(); }
    __device__ __forceinline__ bool tile(long L, Unit& u) const {
        if (L >= nwg) return false;
        int wgid = (int)L; { const int q = nwg / NXCD, r = nwg % NXCD, xcd = wgid % NXCD, off = wgid / NXCD; wgid = (xcd < r ? xcd * (q + 1) : r * (q + 1) + (xcd - r) * q) + off; }
        const int nig = WGM * nN, gid = wgid / nig, fm = gid * WGM, gsz = (nM - fm) < WGM ? (nM - fm) : WGM;
        u.pm = fm + ((wgid % nig) % gsz); u.pn = (wgid % nig) / gsz; u.e = 0; u.rows = nullptr;
        u.a = A + (size_t)u.pm * BM * lda * 2; u.b = Bt + (size_t)u.pn * BM * ldb * 2; return true;
    }
    __device__ __forceinline__ bool next(int i, Unit& u) const { return tile((long)i * G + c, u); }
};
struct DenseLight : DenseOrder {
    int r, nl, cap;
    __device__ __forceinline__ void init_light(int r_, int Q) { r = r_; nl = G - r; cap = r ? (nwg < Q * nl ? nwg : Q * nl) : 0; }
    __device__ __forceinline__ bool next(int i, Unit& u) const {
        long L;
        if (r && c >= r) { const int cl = c - r; const int mine = cl < cap ? (cap - cl + nl - 1) / nl : 0; L = i < mine ? (long)i * nl + cl : (long)cap + (long)(i - mine) * G + c; }
        else L = (long)cap + (long)i * G + c;
        return tile(L, u);
    }
};
struct GroupOrder {
    const char* A; const char* Bt; const int* rows; const LAS int* t2e; long bstride; int lda, ldb, ntile, nN, G, c; bool gather;
    __device__ __forceinline__ bool next(int i, Unit& u) const {
        const long L = (long)i * G + c; if (L >= (long)ntile * nN) return false;
        const int rt = (int)(L / nN); u.pm = rt; u.pn = (int)(L % nN); u.e = t2e[rt];
        u.rows = rows + (size_t)rt * BM; u.a = gather ? A : A + (size_t)rt * BM * lda * 2; u.b = Bt + (size_t)u.e * bstride * 2 + (size_t)u.pn * BM * ldb * 2; return true;
    }
};

template <class Epi, class Sched, bool GATHER, bool ALIGN_EPI>
__device__ __forceinline__ void gemm_phase(LAS unsigned char* lds, int K, int lda, int ldb, const Sched& S, const Epi& E) {
    const int tid = tid_fresh(), wid = __builtin_amdgcn_readfirstlane(tid >> 6), lane = tid & 63, wr = wid >> 2, wc = wid & 3, fr = lane & 15, fq = lane >> 4;
    const int nt = K / BK;
    int Rs[2], C2[2]; unsigned voffB[2], voffA[2][2], voffAn[2][2];
#pragma unroll
    for (int i = 0; i < 2; ++i) { int R, C; stage_rc(tid * 16 + i * 8192, R, C); const int Rb = Epi::PERM ? ((R & ~31) + perm32(R & 31)) : R;
        Rs[i] = R; C2[i] = C * 2; voffB[i] = (unsigned)(Rb * ldb + C) * 2u;
#pragma unroll
        for (int h = 0; h < 2; ++h) { voffA[h][i] = (unsigned)((h * HALF + R) * lda + C) * 2u; voffAn[h][i] = voffA[h][i]; } }
    const size_t kstep = (size_t)(BK * 2);
    const size_t hstepB = (size_t)HALF * ldb * 2;
    const unsigned ldsw = (unsigned)wid * 1024u;
    const int aoff = lds_byte(wr * 64 + fr, fq * 8), boff = lds_byte(wc * 32 + fr, fq * 8);
#define G8_SA(b, h) (((b) * 2 + (h)) * HTB)
#define G8_SB(b, h) ((4 + (b) * 2 + (h)) * HTB)
#define G8_STAGE(bufoff, gbase, voff) do { _Pragma("unroll") for (int _i = 0; _i < 2; ++_i) \
        __builtin_amdgcn_global_load_lds((const unsigned*)((const char*)(gbase) + (voff)[_i]), (LAS unsigned*)(lds + (bufoff) + ldsw + _i * 8192), 16, 0, 0); } while (0)
#define G8_LDA(dst, b, h) do { _Pragma("unroll") for (int m = 0; m < 4; ++m) _Pragma("unroll") for (int k = 0; k < 2; ++k) dst[m][k] = *(const LAS h16x8*)(lds + G8_SA(b, h) + aoff + m * 2048 + k * 1024); } while (0)
#define G8_LDB(dst, b, h) do { _Pragma("unroll") for (int n = 0; n < 2; ++n) _Pragma("unroll") for (int k = 0; k < 2; ++k) dst[n][k] = *(const LAS h16x8*)(lds + G8_SB(b, h) + boff + n * 2048 + k * 1024); } while (0)
#define G8_MMA(ai, bj, At, Bt) do { __builtin_amdgcn_s_setprio(1); _Pragma("unroll") for (int m = 0; m < 4; ++m) _Pragma("unroll") for (int n = 0; n < 2; ++n) _Pragma("unroll") for (int k = 0; k < 2; ++k) \
        acc[ai][bj][m][n] = __builtin_amdgcn_mfma_f32_16x16x32_f16(Bt[n][k], At[m][k], acc[ai][bj][m][n], 0, 0, 0); __builtin_amdgcn_s_setprio(0); } while (0)
#define G8_WAIT_V(n) asm volatile("s_waitcnt vmcnt(" #n ")" ::: "memory")
#define G8_WAIT_L(n) asm volatile("s_waitcnt lgkmcnt(" #n ")" ::: "memory")
#define G8_BAR __builtin_amdgcn_s_barrier()
#define G8_SCHED __builtin_amdgcn_sched_barrier(0)
#define G8_ROWS(dst, u) do { if constexpr (GATHER) { _Pragma("unroll") for (int _h = 0; _h < 2; ++_h) _Pragma("unroll") for (int _i = 0; _i < 2; ++_i) { \
        int _r = (u).rows[_h * HALF + Rs[_i]]; _r = _r < 0 ? 0 : _r; dst[_h][_i] = (unsigned)_r * (unsigned)(lda * 2) + (unsigned)C2[_i]; } } } while (0)
    Unit cur, nxt; int ui = 0;
    if (!S.next(0, cur)) return;
    f32x4 acc[2][2][4][2];
    E.init(acc, cur, wr, wc, fr, fq);
    h16x8 At[4][2], B0[2][2], B1[2][2];
    G8_ROWS(voffA, cur);
    const char* cA = cur.a; const char* cB = cur.b;
    G8_STAGE(G8_SB(0, 0), cB, voffB); G8_STAGE(G8_SB(0, 1), cB + hstepB, voffB); G8_STAGE(G8_SA(0, 0), cA, voffA[0]); G8_STAGE(G8_SA(0, 1), cA, voffA[1]);
    if (wr == 1) G8_BAR;
    G8_WAIT_V(2); G8_BAR;
    G8_STAGE(G8_SB(1, 0), cB + kstep, voffB); G8_STAGE(G8_SA(1, 0), cA + kstep, voffA[0]); G8_STAGE(G8_SB(1, 1), cB + hstepB + kstep, voffB);
    G8_WAIT_V(6); G8_BAR;
    for (;;) {
        const bool has_next = S.next(ui + 1, nxt);
        const char* nA = has_next ? nxt.a : cA; const char* nB = has_next ? nxt.b : cB;
        if constexpr (GATHER) { if (has_next) { G8_ROWS(voffAn, nxt); } else {
#pragma unroll
            for (int h = 0; h < 2; ++h)
#pragma unroll
                for (int i = 0; i < 2; ++i) voffAn[h][i] = voffA[h][i]; } }
#pragma unroll 1
        for (int t = 0; t < nt; t += 2) {
            const bool last = (t == nt - 2);
            const char* a1 = cA + (size_t)(t + 1) * kstep;
            const char* a2 = last ? nA : cA + (size_t)(t + 2) * kstep; const char* b2 = last ? nB : cB + (size_t)(t + 2) * kstep;
            const char* a3 = a2 + kstep; const char* b3 = b2 + kstep;
            unsigned v2[2][2];
#pragma unroll
            for (int h = 0; h < 2; ++h)
#pragma unroll
                for (int i = 0; i < 2; ++i) v2[h][i] = (GATHER && last) ? voffAn[h][i] : voffA[h][i];
            G8_LDB(B0, 0, 0); G8_LDB(B1, 0, 1); G8_SCHED; G8_LDA(At, 0, 0); G8_STAGE(G8_SA(1, 1), a1, voffA[1]);
            G8_WAIT_V(8); G8_WAIT_L(0); G8_BAR; G8_MMA(0, 0, At, B0); G8_MMA(0, 1, At, B1); G8_BAR; G8_SCHED;
            G8_LDA(At, 0, 1); G8_STAGE(G8_SB(0, 0), b2, voffB); G8_STAGE(G8_SB(0, 1), b2 + hstepB, voffB); G8_STAGE(G8_SA(0, 0), a2, v2[0]);
            G8_WAIT_V(8); G8_WAIT_L(0); G8_BAR; G8_MMA(1, 0, At, B0); G8_MMA(1, 1, At, B1); G8_BAR; G8_SCHED;
            G8_LDB(B0, 1, 0); G8_LDB(B1, 1, 1); G8_SCHED; G8_LDA(At, 1, 0); G8_STAGE(G8_SA(0, 1), a2, v2[1]);
            G8_WAIT_V(8); G8_WAIT_L(0); G8_BAR; G8_MMA(0, 0, At, B0); G8_MMA(0, 1, At, B1); G8_BAR; G8_SCHED;
            G8_LDA(At, 1, 1); G8_STAGE(G8_SB(1, 0), b3, voffB); G8_STAGE(G8_SB(1, 1), b3 + hstepB, voffB); G8_STAGE(G8_SA(1, 0), a3, v2[0]);
            G8_WAIT_V(8); G8_WAIT_L(0); G8_BAR; G8_MMA(1, 0, At, B0); G8_MMA(1, 1, At, B1); G8_BAR; G8_SCHED;
        }
        if constexpr (ALIGN_EPI) { if (wr == 0) G8_BAR; }
        E(acc, cur, wr, wc, fr, fq);
        if (!has_next) break;
        E.init(acc, nxt, wr, wc, fr, fq);
        cur = nxt; cA = nA; cB = nB; ++ui;
        if constexpr (GATHER) {
#pragma unroll
            for (int h = 0; h < 2; ++h)
#pragma unroll
                for (int i = 0; i < 2; ++i) voffA[h][i] = voffAn[h][i]; }
        if constexpr (ALIGN_EPI) { if (wr == 1) G8_BAR; }
    }
    G8_WAIT_V(0);
    if constexpr (!ALIGN_EPI) { if (wr == 0) G8_BAR; }
    G8_BAR;
#undef G8_SA
#undef G8_SB
#undef G8_STAGE
#undef G8_LDA
#undef G8_LDB
#undef G8_MMA
#undef G8_WAIT_V
#undef G8_WAIT_L
#undef G8_BAR
#undef G8_SCHED
#undef G8_ROWS
}
__device__ __forceinline__ h16x8 pack8(const f32x4& a, const f32x4& b) { h16x8 r; r[0] = (h16)a[0]; r[1] = (h16)a[1]; r[2] = (h16)a[2]; r[3] = (h16)a[3]; r[4] = (h16)b[0]; r[5] = (h16)b[1]; r[6] = (h16)b[2]; r[7] = (h16)b[3]; return r; }
__device__ __forceinline__ void acc_zero(f32x4 (&acc)[2][2][4][2]) {
#pragma unroll
    for (int a = 0; a < 2; ++a)
#pragma unroll
        for (int b = 0; b < 2; ++b)
#pragma unroll
            for (int m = 0; m < 4; ++m)
#pragma unroll
                for (int n = 0; n < 2; ++n) acc[a][b][m][n] = (f32x4){0.f, 0.f, 0.f, 0.f};
}
struct EpiH { static constexpr bool PERM = true; h16* C; int ldc;
    __device__ __forceinline__ void init(f32x4 (&acc)[2][2][4][2], const Unit&, int, int, int, int) const { acc_zero(acc); }
    __device__ __forceinline__ void operator()(const f32x4 (&acc)[2][2][4][2], const Unit& u, int wr, int wc, int fr, int fq) const {
        const int row0 = u.pm * BM + wr * 64 + fr, col0 = u.pn * BM + wc * 32 + 8 * fq;
#pragma unroll
        for (int ai = 0; ai < 2; ++ai)
#pragma unroll
            for (int m = 0; m < 4; ++m) { h16* rowp = C + (size_t)(row0 + ai * HALF + m * 16) * ldc + col0;
#pragma unroll
                for (int bj = 0; bj < 2; ++bj) *(h16x8*)(rowp + bj * HALF) = pack8(acc[ai][bj][m][0], acc[ai][bj][m][1]); } } };
template <int MODE> struct EpiRes { static constexpr bool PERM = true; const float* Rf; const h16* Rh; h16* Yh; float* Yf;
    __device__ __forceinline__ void init(f32x4 (&acc)[2][2][4][2], const Unit&, int, int, int, int) const { acc_zero(acc); }
    __device__ __forceinline__ void operator()(const f32x4 (&acc)[2][2][4][2], const Unit& u, int wr, int wc, int fr, int fq) const {
        const int row0 = u.pm * BM + wr * 64 + fr, col0 = u.pn * BM + wc * 32 + 8 * fq;
        if constexpr (MODE != 0) {
            h16x8 r[2][4][2];
#pragma unroll
            for (int ai = 0; ai < 2; ++ai)
#pragma unroll
                for (int m = 0; m < 4; ++m) { const size_t ro = (size_t)(row0 + ai * HALF + m * 16) * DM + col0;
#pragma unroll
                    for (int bj = 0; bj < 2; ++bj) r[ai][m][bj] = *(const h16x8*)(Rh + ro + bj * HALF); }
#pragma unroll
            for (int ai = 0; ai < 2; ++ai)
#pragma unroll
                for (int m = 0; m < 4; ++m) { const size_t ro = (size_t)(row0 + ai * HALF + m * 16) * DM + col0;
#pragma unroll
                    for (int bj = 0; bj < 2; ++bj) { const h16x8 h = r[ai][m][bj];
                        const f32x4 v0 = (f32x4){(float)h[0], (float)h[1], (float)h[2], (float)h[3]} * ALPHA + acc[ai][bj][m][0], v1 = (f32x4){(float)h[4], (float)h[5], (float)h[6], (float)h[7]} * ALPHA + acc[ai][bj][m][1];
                        if constexpr (MODE == 2) { *(f32x4*)(Yf + ro + bj * HALF) = v0; *(f32x4*)(Yf + ro + bj * HALF + 4) = v1; }
                        else *(h16x8*)(Yh + ro + bj * HALF) = pack8(v0, v1); } }
        } else {
#pragma unroll
            for (int ai = 0; ai < 2; ++ai) {
                f32x4 r[4][2][2];
#pragma unroll
                for (int m = 0; m < 4; ++m) { const size_t ro = (size_t)(row0 + ai * HALF + m * 16) * DM + col0;
#pragma unroll
                    for (int bj = 0; bj < 2; ++bj) { r[m][bj][0] = *(const f32x4*)(Rf + ro + bj * HALF); r[m][bj][1] = *(const f32x4*)(Rf + ro + bj * HALF + 4); } }
#pragma unroll
                for (int m = 0; m < 4; ++m) { const size_t ro = (size_t)(row0 + ai * HALF + m * 16) * DM + col0;
#pragma unroll
                    for (int bj = 0; bj < 2; ++bj) *(h16x8*)(Yh + ro + bj * HALF) = pack8(r[m][bj][0] * ALPHA + acc[ai][bj][m][0], r[m][bj][1] * ALPHA + acc[ai][bj][m][1]); } } }
    } };
struct EpiResStat { static constexpr bool PERM = true; const h16* Rh; h16* Yh; f32x2* stat;
    __device__ __forceinline__ void init(f32x4 (&acc)[2][2][4][2], const Unit&, int, int, int, int) const { acc_zero(acc); }
    __device__ __forceinline__ void operator()(const f32x4 (&acc)[2][2][4][2], const Unit& u, int wr, int wc, int fr, int fq) const {
        const int row0 = u.pm * BM + wr * 64 + fr, col0 = u.pn * BM + wc * 32 + 8 * fq;
        h16x8 r[2][4][2];
#pragma unroll
        for (int ai = 0; ai < 2; ++ai)
#pragma unroll
            for (int m = 0; m < 4; ++m) { const size_t ro = (size_t)(row0 + ai * HALF + m * 16) * DM + col0;
#pragma unroll
                for (int bj = 0; bj < 2; ++bj) r[ai][m][bj] = *(const h16x8*)(Rh + ro + bj * HALF); }
#pragma unroll
        for (int ai = 0; ai < 2; ++ai)
#pragma unroll
            for (int m = 0; m < 4; ++m) { const int row = row0 + ai * HALF + m * 16; const size_t ro = (size_t)row * DM + col0; float s1 = 0.f, s2 = 0.f;
#pragma unroll
                for (int bj = 0; bj < 2; ++bj) { const h16x8 h = r[ai][m][bj];
                    const f32x4 v0 = (f32x4){(float)h[0], (float)h[1], (float)h[2], (float)h[3]} * ALPHA + acc[ai][bj][m][0], v1 = (f32x4){(float)h[4], (float)h[5], (float)h[6], (float)h[7]} * ALPHA + acc[ai][bj][m][1];
                    const h16x8 o = pack8(v0, v1); *(h16x8*)(Yh + ro + bj * HALF) = o;
#pragma unroll
                    for (int e = 0; e < 8; ++e) { const float f = (float)o[e]; s1 += f; s2 += f * f; } }
                s1 += shx(s1, 16); s2 += shx(s2, 16); s1 = half_sum(s1); s2 = half_sum(s2);
                if (fq == 0) stat[(size_t)row * 16 + u.pn * 4 + wc] = (f32x2){s1, s2}; } } };
struct EpiLnQ { static constexpr bool PERM = true; h16* C; int ldc; const f32x2* murs; const float* csbw;
    __device__ __forceinline__ void init(f32x4 (&acc)[2][2][4][2], const Unit&, int, int, int, int) const { acc_zero(acc); }
    __device__ __forceinline__ void operator()(const f32x4 (&acc)[2][2][4][2], const Unit& u, int wr, int wc, int fr, int fq) const {
        const int row0 = u.pm * BM + wr * 64 + fr, col0 = u.pn * BM + wc * 32 + 8 * fq;
        f32x4 cs[2][2], bw[2][2]; f32x2 mr[2][4];
#pragma unroll
        for (int bj = 0; bj < 2; ++bj)
#pragma unroll
            for (int n = 0; n < 2; ++n) { cs[bj][n] = *(const f32x4*)(csbw + col0 + bj * HALF + 4 * n); bw[bj][n] = *(const f32x4*)(csbw + 512 + col0 + bj * HALF + 4 * n); }
#pragma unroll
        for (int ai = 0; ai < 2; ++ai)
#pragma unroll
            for (int m = 0; m < 4; ++m) mr[ai][m] = murs[row0 + ai * HALF + m * 16];
#pragma unroll
        for (int ai = 0; ai < 2; ++ai)
#pragma unroll
            for (int m = 0; m < 4; ++m) { h16* rowp = C + (size_t)(row0 + ai * HALF + m * 16) * ldc + col0; const float mu = mr[ai][m][0], rs = mr[ai][m][1];
#pragma unroll
                for (int bj = 0; bj < 2; ++bj) *(h16x8*)(rowp + bj * HALF) = pack8((acc[ai][bj][m][0] - cs[bj][0] * mu) * rs + bw[bj][0], (acc[ai][bj][m][1] - cs[bj][1] * mu) * rs + bw[bj][1]); } } };
struct EpiResLn { static constexpr bool PERM = true; const h16* Rh; h16* Yh; const f32x2* murs; const float* g; const float* b;
    __device__ __forceinline__ void init(f32x4 (&acc)[2][2][4][2], const Unit&, int, int, int, int) const { acc_zero(acc); }
    __device__ __forceinline__ void operator()(const f32x4 (&acc)[2][2][4][2], const Unit& u, int wr, int wc, int fr, int fq) const {
        const int row0 = u.pm * BM + wr * 64 + fr, col0 = u.pn * BM + wc * 32 + 8 * fq;
        f32x4 g4[2][2], b4[2][2];
#pragma unroll
        for (int bj = 0; bj < 2; ++bj)
#pragma unroll
            for (int n = 0; n < 2; ++n) { g4[bj][n] = *(const f32x4*)(g + col0 + bj * HALF + 4 * n); b4[bj][n] = *(const f32x4*)(b + col0 + bj * HALF + 4 * n); }
#pragma unroll
        for (int ai = 0; ai < 2; ++ai) {
            h16x8 r[4][2]; f32x2 mr[4];
#pragma unroll
            for (int m = 0; m < 4; ++m) { const int row = row0 + ai * HALF + m * 16; const size_t ro = (size_t)row * DM + col0; mr[m] = murs[row];
#pragma unroll
                for (int bj = 0; bj < 2; ++bj) r[m][bj] = *(const h16x8*)(Rh + ro + bj * HALF); }
#pragma unroll
            for (int m = 0; m < 4; ++m) { const size_t ro = (size_t)(row0 + ai * HALF + m * 16) * DM + col0; const float mu = mr[m][0], rs = mr[m][1];
#pragma unroll
                for (int bj = 0; bj < 2; ++bj) { const h16x8 h = r[m][bj];
                    const f32x4 n0 = ((f32x4){(float)h[0], (float)h[1], (float)h[2], (float)h[3]} - mu) * rs * g4[bj][0] + b4[bj][0], n1 = ((f32x4){(float)h[4], (float)h[5], (float)h[6], (float)h[7]} - mu) * rs * g4[bj][1] + b4[bj][1];
                    *(h16x8*)(Yh + ro + bj * HALF) = pack8(n0 * ALPHA + acc[ai][bj][m][0], n1 * ALPHA + acc[ai][bj][m][1]); } } } } };
struct EpiGU { static constexpr bool PERM = false; h16* Hs; const float* roww;
    __device__ __forceinline__ void init(f32x4 (&acc)[2][2][4][2], const Unit&, int, int, int, int) const { acc_zero(acc); }
    __device__ __forceinline__ void operator()(const f32x4 (&acc)[2][2][4][2], const Unit& u, int wr, int wc, int fr, int fq) const {
        const int row0 = u.pm * BM + wr * 64 + fr, hc0 = u.pn * 128 + wc * 32 + 8 * fq;
        float w[2][4];
#pragma unroll
        for (int ai = 0; ai < 2; ++ai)
#pragma unroll
            for (int m = 0; m < 4; ++m) w[ai][m] = roww ? roww[row0 + ai * HALF + m * 16] : 1.f;
#pragma unroll
        for (int ai = 0; ai < 2; ++ai)
#pragma unroll
            for (int m = 0; m < 4; ++m) { const int row = row0 + ai * HALF + m * 16; h16x8 o;
#pragma unroll
                for (int bj = 0; bj < 2; ++bj) { const f32x4 g = acc[ai][bj][m][0], up = acc[ai][bj][m][1];
#pragma unroll
                    for (int j = 0; j < 4; ++j) o[4 * bj + j] = (h16)(g[j] / (1.f + __expf(-g[j])) * up[j] * w[ai][m]); }
                *(h16x8*)(Hs + (size_t)row * EDIM + hc0) = o; } } };
constexpr float YSCALE = 16.f;
__device__ __forceinline__ unsigned pk4_fp8(const f32x4& v) {
    const float a = __builtin_amdgcn_fmed3f(v[0] * YSCALE, -448.f, 448.f), b = __builtin_amdgcn_fmed3f(v[1] * YSCALE, -448.f, 448.f),
                c = __builtin_amdgcn_fmed3f(v[2] * YSCALE, -448.f, 448.f), d = __builtin_amdgcn_fmed3f(v[3] * YSCALE, -448.f, 448.f);
    int w = 0; w = __builtin_amdgcn_cvt_pk_fp8_f32(a, b, w, false); w = __builtin_amdgcn_cvt_pk_fp8_f32(c, d, w, true); return (unsigned)w; }
struct EpiDn { static constexpr bool PERM = false; unsigned char* Y8; const int* rowdst;
    __device__ __forceinline__ void init(f32x4 (&acc)[2][2][4][2], const Unit&, int, int, int, int) const { acc_zero(acc); }
    __device__ __forceinline__ void operator()(const f32x4 (&acc)[2][2][4][2], const Unit& u, int wr, int wc, int fr, int fq) const {
        const int row0 = u.pm * BM + wr * 64 + fr, col0 = u.pn * BM + wc * 64 + 16 * fq;
        int d[2][4];
#pragma unroll
        for (int ai = 0; ai < 2; ++ai)
#pragma unroll
            for (int m = 0; m < 4; ++m) d[ai][m] = rowdst[row0 + ai * HALF + m * 16];
#pragma unroll
        for (int ai = 0; ai < 2; ++ai)
#pragma unroll
            for (int m = 0; m < 4; ++m) { typedef unsigned u32x4_ __attribute__((ext_vector_type(4)));
                const u32x4_ w = {pk4_fp8(acc[ai][0][m][0]), pk4_fp8(acc[ai][0][m][1]), pk4_fp8(acc[ai][1][m][0]), pk4_fp8(acc[ai][1][m][1])};
                *(u32x4_*)(Y8 + (size_t)d[ai][m] * DM + col0) = w; } } };
}
__device__ __forceinline__ void ph_murs(const g8::DenseOrder& S, const f32x2* __restrict__ stat, f32x2* __restrict__ murs) {
    g8::Unit u; const int tid = tid_fresh();
    for (int i = 0; S.next(i, u); ++i) if (tid < 256) {
        const int row = u.pm * 256 + tid; const f32x4* p = (const f32x4*)(stat + (size_t)row * 16);
        float s1 = 0.f, s2 = 0.f;
#pragma unroll
        for (int q = 0; q < 8; ++q) { const f32x4 v = p[q]; s1 += v[0]; s2 += v[1]; s1 += v[2]; s2 += v[3]; }
        const float mu = s1 * (1.f / DM), var = s2 * (1.f / DM) - mu * mu;
        murs[row] = (f32x2){mu, rsqrtf((var > 0.f ? var : 0.f) + LN_EPS)};
    }
    asm volatile("s_waitcnt vmcnt(0)" ::: "memory"); __syncthreads();
}
__device__ __forceinline__ int ph_tile_map(LAS int* t2e, const int* __restrict__ off) {
    const int tid = tid_fresh(); const int ntile = off[NE] >> 8;
    __syncthreads();
    for (int rt = tid; rt < ntile; rt += NTHR) { int e = 0; while (e < NE - 1 && rt * 256 >= off[e + 1]) ++e; t2e[rt] = e; }
    __syncthreads();
    return ntile;
}

namespace fa {
typedef short s16x4 __attribute__((ext_vector_type(4)));
typedef unsigned u32x4 __attribute__((ext_vector_type(4)));
#define FA_SBAR() __builtin_amdgcn_sched_barrier(0)
constexpr float THR = 8.f;
template <int MODE> struct Cfg {
    static constexpr int DQK = MODE == 0 ? 64 : (MODE == 1 ? 192 : 128), NQ = DQK / 16, ROWB = DQK * 2, SHM_K = 64 * ROWB, SHM_V = 64 * 128 * 2, SDEPTH = MODE == 1 ? 1 : 2;
    static constexpr float SCALE = MODE == 0 ? 0.125f : (MODE == 1 ? 0.07216878364870322f : 0.08838834764831845f);
    static constexpr int NKP = MODE == 0 ? 1 : (MODE == 1 ? 3 : 2);
};
template <int MODE> __device__ __forceinline__ int kswz(int row, int c) {
    if (MODE == 2) return row * 256 + ((c ^ (row & 15)) << 4);
    return row * Cfg<MODE>::ROWB + (((c & ~7) | ((c & 7) ^ ((row >> 1) & 7))) << 4);
}
__device__ __forceinline__ unsigned cvtpk(float lo, float hi) { f32x2 v = {lo, hi}; h16x2 h = __builtin_convertvector(v, h16x2); return __builtin_bit_cast(unsigned, h); }
__device__ __forceinline__ int v_st(int k, int c) { const int kk = (k & ~0xC) | ((k & 4) << 1) | ((k & 8) >> 1); return ((kk >> 3) * 4 + (c >> 5)) * 512 + ((kk & 7) * 32 + (c & 31)) * 2; }
__device__ __forceinline__ int v_rd_base(int lane) { return ((lane & 3) << 3) | (((lane >> 2) & 3) << 6) | (((lane >> 4) & 1) << 5) | (((lane >> 5) & 1) << 8); }
constexpr int v_rd_off(int d0, int ks, int half) { return d0 * 512 + ks * 4096 + half * 2048; }
template <int OFF> __device__ __forceinline__ s16x4 tr_read(int vb) { s16x4 r; asm volatile("ds_read_b64_tr_b16 %0, %1 offset:%2" : "=&v"(r) : "v"(vb), "i"(OFF) : "memory"); return r; }
template <int D0> __device__ __forceinline__ void pv_one(f32x16& od, int vb, h16x8 pa0, h16x8 pa1, h16x8 pa2, h16x8 pa3) {
    const s16x4 l0 = tr_read<v_rd_off(D0, 0, 0)>(vb), h0 = tr_read<v_rd_off(D0, 0, 1)>(vb), l1 = tr_read<v_rd_off(D0, 1, 0)>(vb), h1 = tr_read<v_rd_off(D0, 1, 1)>(vb);
    const s16x4 l2 = tr_read<v_rd_off(D0, 2, 0)>(vb), h2 = tr_read<v_rd_off(D0, 2, 1)>(vb), l3 = tr_read<v_rd_off(D0, 3, 0)>(vb), h3 = tr_read<v_rd_off(D0, 3, 1)>(vb);
    asm volatile("s_waitcnt lgkmcnt(0)" ::: "memory"); FA_SBAR();
#define FA_PK(L, H) __builtin_bit_cast(h16x8, (short __attribute__((ext_vector_type(8)))){L[0], L[1], L[2], L[3], H[0], H[1], H[2], H[3]})
    od = __builtin_amdgcn_mfma_f32_32x32x16_f16(pa0, FA_PK(l0, h0), od, 0, 0, 0);
    od = __builtin_amdgcn_mfma_f32_32x32x16_f16(pa1, FA_PK(l1, h1), od, 0, 0, 0);
    od = __builtin_amdgcn_mfma_f32_32x32x16_f16(pa2, FA_PK(l2, h2), od, 0, 0, 0);
    od = __builtin_amdgcn_mfma_f32_32x32x16_f16(pa3, FA_PK(l3, h3), od, 0, 0, 0);
#undef FA_PK
}
__device__ __forceinline__ void pv_d0(f32x16* o, int vb, h16x8 pa0, h16x8 pa1, h16x8 pa2, h16x8 pa3) {
    pv_one<0>(o[0], vb, pa0, pa1, pa2, pa3); pv_one<1>(o[1], vb, pa0, pa1, pa2, pa3); pv_one<2>(o[2], vb, pa0, pa1, pa2, pa3); pv_one<3>(o[3], vb, pa0, pa1, pa2, pa3);
}
template <int MODE> __device__ __forceinline__ void partialSM(f32x16& p0, f32x16& p1, float& m_reg, float& mn, float& alpha) {
    constexpr float C = Cfg<MODE>::SCALE * LOG2E;
    float pmax = p0[0];
#pragma unroll
    for (int r = 1; r < 16; ++r) pmax = fmaxf(pmax, p0[r]);
#pragma unroll
    for (int r = 0; r < 16; ++r) pmax = fmaxf(pmax, p1[r]);
    { auto rr = __builtin_amdgcn_permlane32_swap(__float_as_uint(pmax), __float_as_uint(pmax), false, false); pmax = fmaxf(__uint_as_float(rr[0]), __uint_as_float(rr[1])); }
    if (__builtin_expect(__all(pmax - m_reg <= THR / Cfg<MODE>::SCALE), 1)) { mn = m_reg; alpha = 1.f; }
    else { mn = fmaxf(m_reg, pmax); alpha = __builtin_amdgcn_exp2f((m_reg - mn) * C); m_reg = mn; }
    const float mnC = -mn * C;
#pragma unroll
    for (int r = 0; r < 16; ++r) p0[r] = fmaf(p0[r], C, mnC);
#pragma unroll
    for (int r = 0; r < 16; ++r) p1[r] = fmaf(p1[r], C, mnC);
#pragma unroll
    for (int r = 0; r < 16; ++r) p0[r] = __builtin_amdgcn_exp2f(p0[r]);
}
__device__ __forceinline__ void finishSM(f32x16& p0, f32x16& p1, float alpha, float& l_reg, h16x8& pa0, h16x8& pa1, h16x8& pa2, h16x8& pa3) {
#pragma unroll
    for (int r = 0; r < 16; ++r) p1[r] = __builtin_amdgcn_exp2f(p1[r]);
    float ps = 0;
#pragma unroll
    for (int r = 0; r < 16; ++r) ps += p0[r];
#pragma unroll
    for (int r = 0; r < 16; ++r) ps += p1[r];
    { auto rr = __builtin_amdgcn_permlane32_swap(__float_as_uint(ps), __float_as_uint(ps), false, false); ps = __uint_as_float(rr[0]) + __uint_as_float(rr[1]); }
    l_reg = l_reg * alpha + ps;
#define FA_PK4(P, BASE, OUT) do { unsigned a0 = cvtpk(P[BASE + 0], P[BASE + 1]), a1 = cvtpk(P[BASE + 2], P[BASE + 3]); \
    unsigned b0 = cvtpk(P[BASE + 4], P[BASE + 5]), b1 = cvtpk(P[BASE + 6], P[BASE + 7]); \
    auto r0 = __builtin_amdgcn_permlane32_swap(a0, b0, false, false); auto r1 = __builtin_amdgcn_permlane32_swap(a1, b1, false, false); \
    u32x4 w = {r0[0], r1[0], r0[1], r1[1]}; OUT = __builtin_bit_cast(h16x8, w); } while (0)
    FA_PK4(p0, 0, pa0); FA_PK4(p0, 8, pa1); FA_PK4(p1, 0, pa2); FA_PK4(p1, 8, pa3);
#undef FA_PK4
}
template <int MODE> __device__ __forceinline__ void qkt(f32x16& p0, f32x16& p1, const char* Ks, const h16x8* qr, const char* qpe, int r32, int hi) {
    p0 = f32x16{}; p1 = f32x16{};
#pragma unroll
    for (int d0 = 0; d0 < Cfg<MODE>::NQ; ++d0) {
        const h16x8 b0 = *reinterpret_cast<const h16x8*>(Ks + kswz<MODE>(r32, 2 * d0 + hi));
        const h16x8 b1 = *reinterpret_cast<const h16x8*>(Ks + kswz<MODE>(32 + r32, 2 * d0 + hi));
        const h16x8 qf = (MODE == 1 && d0 >= 5) ? *reinterpret_cast<const h16x8*>(qpe + (d0 - 5) * 1024) : qr[d0];
        p0 = __builtin_amdgcn_mfma_f32_32x32x16_f16(b0, qf, p0, 0, 0, 0);
        p1 = __builtin_amdgcn_mfma_f32_32x32x16_f16(b1, qf, p1, 0, 0, 0); }
}
__device__ __forceinline__ void cmask(f32x16& p0, f32x16& p1, int kb0, int qrel, int hi) {
    const int kb = kb0 + 4 * hi;
#pragma unroll
    for (int r = 0; r < 16; ++r) { const int kv = kb + (r & 3) + 8 * (r >> 2); if (kv > qrel) p0[r] = -INFINITY; if (kv + 32 > qrel) p1[r] = -INFINITY; }
}
template <int MODE>
__device__ __forceinline__ void attn_unit(const h16* __restrict__ Qg, int ldq, const h16* __restrict__ Kg, int ldk, const h16* __restrict__ Kg2, int ldk2, const h16* __restrict__ Vg, int ldv,
                                          h16* __restrict__ Og, int ldo, int nkeys, int q0, char* lds, int epi, const float* __restrict__ gain, float lam, const float* __restrict__ ropeq) {
    using C = Cfg<MODE>; constexpr int NQ = C::NQ, SHM_K = C::SHM_K, SHM_V = C::SHM_V, SDEPTH = C::SDEPTH;
    const int tid = tid_fresh(), wid = tid >> 6, lane = tid & 63, r32 = lane & 31, hi = lane >> 5;
    char* V_lds = lds; char* K_lds = lds + 2 * SHM_V;
    float* wsf = (float*)(lds + 2 * SHM_V + 2 * SHM_K) + wid * 64; float* li_l = wsf; float* al_l = wsf + 32;
    float m_reg = -1e30f, l_reg = 0; f32x16 o[4] = {}; h16x8 qr[NQ];
    const h16* Qw = Qg + (size_t)(wid * 32 + r32) * ldq + hi * 8;
#pragma unroll
    for (int d0 = 0; d0 < NQ; ++d0) qr[d0] = *reinterpret_cast<const h16x8*>(Qw + d0 * 16);
    if constexpr (MODE == 1) {
        const float* cr = ropeq + (size_t)(wid * 32 + r32) * 32 + 8 * hi; const float* sr_ = cr + (size_t)T * 32;
#pragma unroll
        for (int blk = 0; blk < 2; ++blk) { const f32x8 c8 = *(const f32x8*)(cr + 16 * blk), s8 = *(const f32x8*)(sr_ + 16 * blk);
#pragma unroll
            for (int j = 0; j < 8; ++j) { const float x1 = (float)qr[8 + blk][j], x2 = (float)qr[10 + blk][j];
                qr[8 + blk][j] = (h16)(x1 * c8[j] - x2 * s8[j]); qr[10 + blk][j] = (h16)(x2 * c8[j] + x1 * s8[j]); } }
    }
    char* qpe = lds + 84 * 1024 + wid * 7168 + lane * 16;
    if constexpr (MODE == 1) {
#pragma unroll
        for (int f = 0; f < 7; ++f) *reinterpret_cast<h16x8*>(qpe + f * 1024) = qr[5 + f];
    }
    if constexpr (MODE == 0) {
        const float* cr = ropeq + (size_t)(wid * 32 + r32) * 8 + 4 * hi; const f32x4 c4 = *(const f32x4*)cr, s4 = *(const f32x4*)(cr + (size_t)T * 8);
#pragma unroll
        for (int j = 0; j < 4; ++j) { const float x1 = (float)qr[0][j], x2 = (float)qr[0][4 + j]; qr[0][j] = (h16)(x1 * c4[j] - x2 * s4[j]); qr[0][4 + j] = (h16)(x2 * c4[j] + x1 * s4[j]); }
    }
    const int sr = tid >> 4, sc = (tid & 15) * 8, vst0 = v_st(sr, sc), vst1 = v_st(32 + sr, sc);
    const int kr8 = tid >> 3, kc8 = tid & 7;
    const int vb0 = (int)(uintptr_t)V_lds + v_rd_base(lane);
    struct { h16x8 vs0, vs1, k0, k1, k2; } st[SDEPTH];
#define FA_SLOAD(i, key0) do { st[i].vs0 = *(const h16x8*)(Vg + (size_t)((key0) + sr) * ldv + sc); st[i].vs1 = *(const h16x8*)(Vg + (size_t)((key0) + 32 + sr) * ldv + sc); \
        if (MODE == 0) { st[i].k0 = *(const h16x8*)(Kg + (size_t)((key0) + kr8) * ldk + kc8 * 8); } \
        else { st[i].k0 = *(const h16x8*)(Kg + (size_t)((key0) + sr) * ldk + sc); st[i].k1 = *(const h16x8*)(Kg + (size_t)((key0) + 32 + sr) * ldk + sc); \
               if (MODE == 1) st[i].k2 = *(const h16x8*)(Kg2 + (size_t)((key0) + kr8) * ldk2 + kc8 * 8); } } while (0)
#define FA_SWRITE(b, i) do { *(h16x8*)(V_lds + (b) * SHM_V + vst0) = st[i].vs0; *(h16x8*)(V_lds + (b) * SHM_V + vst1) = st[i].vs1; \
        if (MODE == 0) { *(h16x8*)(K_lds + (b) * SHM_K + kswz<MODE>(kr8, kc8)) = st[i].k0; } \
        else { *(h16x8*)(K_lds + (b) * SHM_K + kswz<MODE>(sr, tid & 15)) = st[i].k0; *(h16x8*)(K_lds + (b) * SHM_K + kswz<MODE>(32 + sr, tid & 15)) = st[i].k1; \
               if (MODE == 1) *(h16x8*)(K_lds + (b) * SHM_K + kswz<MODE>(kr8, 16 + kc8)) = st[i].k2; } } while (0)
#define FA_SWAIT() do { if constexpr (SDEPTH == 2) { if (MODE == 0) asm volatile("s_waitcnt vmcnt(3)" ::: "memory"); else asm volatile("s_waitcnt vmcnt(4)" ::: "memory"); } else asm volatile("s_waitcnt vmcnt(0)" ::: "memory"); } while (0)
#define FA_RESC(a) do { if (__any((a) < 1.f)) { if (hi == 0) al_l[r32] = (a); asm volatile("s_waitcnt lgkmcnt(0)" ::: "memory"); \
        _Pragma("unroll") for (int d = 0; d < 4; ++d) _Pragma("unroll") for (int r = 0; r < 16; ++r) o[d][r] *= al_l[crow(r, hi)]; } } while (0)
#define FA_MASK(P0, P1, j) do { if (MODE != 2) { const int kb0_ = (j) * 64 - q0; if (kb0_ + 63 > wid * 32) cmask(P0, P1, kb0_, wid * 32 + r32, hi); } } while (0)
    h16x8 pa0, pa1, pa2, pa3; const int NT = nkeys / 64;
    f32x16 pA0, pA1, pB0, pB1; float mnA, mnB, alA, alB;
    constexpr int SE = 0, SO = SDEPTH - 1;
    FA_SLOAD(SE, 0); asm volatile("s_waitcnt vmcnt(0)" ::: "memory"); FA_SWRITE(0, SE); __syncthreads();
    qkt<MODE>(pA0, pA1, K_lds, qr, qpe, r32, hi); FA_MASK(pA0, pA1, 0); partialSM<MODE>(pA0, pA1, m_reg, mnA, alA);
    FA_SLOAD(SO, 64); if constexpr (SDEPTH == 2) { if (2 < NT) FA_SLOAD(SE, 128); }
    FA_SWAIT(); FA_SWRITE(1, SO); __syncthreads();
    for (int j = 1; j + 1 < NT; j += 2) {
        FA_SBAR(); qkt<MODE>(pB0, pB1, K_lds + SHM_K, qr, qpe, r32, hi); FA_MASK(pB0, pB1, j);
        finishSM(pA0, pA1, alA, l_reg, pa0, pa1, pa2, pa3); FA_SBAR();
        FA_SLOAD(SO, (j + SDEPTH) * 64); FA_SBAR();
        pv_d0(o, vb0, pa0, pa1, pa2, pa3); partialSM<MODE>(pB0, pB1, m_reg, mnB, alB);
        __syncthreads(); FA_SWAIT(); FA_SWRITE(0, SE);
        FA_RESC(alB); __syncthreads();
        FA_SBAR(); qkt<MODE>(pA0, pA1, K_lds, qr, qpe, r32, hi); FA_MASK(pA0, pA1, j + 1);
        finishSM(pB0, pB1, alB, l_reg, pa0, pa1, pa2, pa3); FA_SBAR();
        if (SDEPTH == 1 || j + 3 < NT) FA_SLOAD(SE, (j + 1 + SDEPTH) * 64); FA_SBAR();
        pv_d0(o, vb0 + SHM_V, pa0, pa1, pa2, pa3); partialSM<MODE>(pA0, pA1, m_reg, mnA, alA);
        __syncthreads(); FA_SWAIT(); FA_SWRITE(1, SO);
        FA_RESC(alA); __syncthreads();
    }
    const int tid_t = tid_fresh(), lane_t = tid_t & 63, wid_t = tid_t >> 6, r32_t = lane_t & 31, hi_t = lane_t >> 5;
    char* qpe_t = lds + 84 * 1024 + wid_t * 7168 + lane_t * 16; const int vb0_t = (int)(uintptr_t)V_lds + v_rd_base(lane_t);
    float* al_t = (float*)(lds + 2 * SHM_V + 2 * SHM_K) + wid_t * 64 + 32;
    FA_SBAR(); qkt<MODE>(pB0, pB1, K_lds + SHM_K, qr, qpe_t, r32_t, hi_t);
    if (MODE != 2) { const int kb0_ = (NT - 1) * 64 - q0; if (kb0_ + 63 > wid_t * 32) cmask(pB0, pB1, kb0_, wid_t * 32 + r32_t, hi_t); }
    finishSM(pA0, pA1, alA, l_reg, pa0, pa1, pa2, pa3); FA_SBAR();
    pv_d0(o, vb0_t, pa0, pa1, pa2, pa3); partialSM<MODE>(pB0, pB1, m_reg, mnB, alB);
    __syncthreads();
    if (__any(alB < 1.f)) { if (hi_t == 0) al_t[r32_t] = alB; asm volatile("s_waitcnt lgkmcnt(0)" ::: "memory");
#pragma unroll
        for (int d = 0; d < 4; ++d)
#pragma unroll
            for (int r = 0; r < 16; ++r) o[d][r] *= al_t[crow(r, hi_t)]; }
    finishSM(pB0, pB1, alB, l_reg, pa0, pa1, pa2, pa3); FA_SBAR();
    pv_d0(o, vb0_t + SHM_V, pa0, pa1, pa2, pa3);
    const int tid_e = tid_fresh(), lane_e = tid_e & 63, wid_e = tid_e >> 6, r32_e = lane_e & 31, hi_e = lane_e >> 5;
    float* li_e = (float*)(lds + 2 * SHM_V + 2 * SHM_K) + wid_e * 64;
    if (hi_e == 0) li_e[r32_e] = l_reg; asm volatile("s_waitcnt lgkmcnt(0)" ::: "memory");
    float rli[16];
#pragma unroll
    for (int r = 0; r < 16; ++r) rli[r] = __builtin_amdgcn_rcpf(li_e[crow(r, hi_e)]);
    __syncthreads();
    constexpr int STASH = 72 * 1024;
    char* stg = lds + ((MODE == 0 && epi == 0) ? STASH : 0) + wid_e * (32 * 272);
#pragma unroll
    for (int r = 0; r < 16; ++r) { const int orow = crow(r, hi_e);
#pragma unroll
        for (int d0 = 0; d0 < 4; ++d0) *(h16*)(stg + orow * 272 + (d0 * 32 + r32_e) * 2) = (h16)(o[d0][r] * rli[r]); }
    asm volatile("s_waitcnt lgkmcnt(0)" ::: "memory");
    if (!(MODE == 0 && epi == 0)) {
        h16* Ow = Og + (size_t)(wid_e * 32) * ldo; const int ch = lane_e & 15;
        f32x8 g8v; if constexpr (MODE != 2) g8v = *(const f32x8*)(gain + ch * 8);
#pragma unroll
        for (int i = 0; i < 8; ++i) { const int row = i * 4 + (lane_e >> 4);
            if constexpr (MODE == 2) { *(u32x4*)(Ow + (size_t)row * ldo + ch * 8) = *(const u32x4*)(stg + row * 272 + ch * 16); }
            else {
                const h16x8 a = *(const h16x8*)(stg + row * 272 + ch * 16); float v[8];
                if constexpr (MODE == 0) { const h16x8 a1 = *(const h16x8*)(lds + STASH + wid_e * (32 * 272) + row * 272 + ch * 16);
#pragma unroll
                    for (int e = 0; e < 8; ++e) v[e] = (float)a1[e] - lam * (float)a[e]; }
                else {
#pragma unroll
                    for (int e = 0; e < 8; ++e) v[e] = (float)a[e]; }
                float ss = 0.f;
#pragma unroll
                for (int e = 0; e < 8; ++e) ss += v[e] * v[e];
                ss += shx(ss, 1); ss += shx(ss, 2); ss += shx(ss, 4); ss += shx(ss, 8);
                const float rs = rsqrtf(ss * (1.f / 128.f) + RMS_EPS) * (MODE == 0 ? 0.8f : 1.f); h16x8 ov;
#pragma unroll
                for (int e = 0; e < 8; ++e) ov[e] = (h16)(v[e] * rs * g8v[e]);
                *(h16x8*)(Ow + (size_t)row * ldo + ch * 8) = ov; } }
    }
    __syncthreads();
#undef FA_SLOAD
#undef FA_SWRITE
#undef FA_SWAIT
#undef FA_RESC
#undef FA_MASK
}
}
namespace fd {
typedef short s16x4 __attribute__((ext_vector_type(4)));
typedef short v4i16_t __attribute__((ext_vector_type(4)));
typedef unsigned u32x4 __attribute__((ext_vector_type(4)));
typedef __attribute__((address_space(3))) const char* lds_cptr;
#define FD_SBAR() __builtin_amdgcn_sched_barrier(0)
constexpr int NSLK = 4, NSLV = 3, KSLOT = 8192, VSLOT = 16384;
constexpr int LDS_K = 0, LDS_V = NSLK * KSLOT, LDS_WS = LDS_V + NSLV * VSLOT, LDS_STASH = LDS_WS + 2048, LDS_END = LDS_STASH + 8 * 32 * 272;
constexpr float C2 = 0.125f * LOG2E;
__device__ __forceinline__ void glds16(const void* gsrc, unsigned lds_dst) { unsigned keep;
    asm volatile("s_mov_b32 %0, m0\n\ts_mov_b32 m0, %2\n\ts_nop 0\n\tglobal_load_lds_dwordx4 %1, off\n\ts_mov_b32 m0, %0" : "=&s"(keep) : "v"(gsrc), "s"(lds_dst) : "memory"); }
__device__ __forceinline__ float max3f(float a, float b, float c) { float r; asm("v_max3_f32 %0, %1, %2, %3" : "=v"(r) : "v"(a), "v"(b), "v"(c)); return r; }
__device__ __forceinline__ float max2f(float a, float b) { float r; asm("v_max_f32_e32 %0, %1, %2" : "=v"(r) : "v"(a), "v"(b)); return r; }
__device__ __forceinline__ float fadd_s(float a, float b) { float r; asm("v_add_f32_e32 %0, %1, %2" : "=v"(r) : "v"(a), "v"(b)); return r; }
__device__ __forceinline__ float fsub_s(float a, float b) { float r; asm("v_sub_f32_e32 %0, %1, %2" : "=v"(r) : "v"(a), "v"(b)); return r; }
__device__ __forceinline__ unsigned cvtpk_s(float lo, float hi) { f32x2 v = {lo, hi}; h16x2 h = __builtin_convertvector(v, h16x2); return __builtin_bit_cast(unsigned, h); }
#define FD_WAIT_BAR(N) asm volatile("s_waitcnt vmcnt(" #N ") lgkmcnt(0)\n\ts_barrier" ::: "memory")
__device__ __forceinline__ void qkt(f32x16& p0, f32x16& p1, const char* Kslot, const h16x8* qr, int r32, int hi) {
    const f32x16 negm = f32x16{};
    const char* kb = Kslot + hi * 1024 + r32 * 16;
#pragma unroll
    for (int d0 = 0; d0 < 4; ++d0) {
        const h16x8 b0 = *reinterpret_cast<const h16x8*>(kb + d0 * 2048);
        const h16x8 b1 = *reinterpret_cast<const h16x8*>(kb + d0 * 2048 + 512);
        if (d0 == 0) { p0 = __builtin_amdgcn_mfma_f32_32x32x16_f16(b0, qr[0], negm, 0, 0, 0); p1 = __builtin_amdgcn_mfma_f32_32x32x16_f16(b1, qr[0], negm, 0, 0, 0); }
        else { p0 = __builtin_amdgcn_mfma_f32_32x32x16_f16(b0, qr[d0], p0, 0, 0, 0); p1 = __builtin_amdgcn_mfma_f32_32x32x16_f16(b1, qr[d0], p1, 0, 0, 0); } }
}
__device__ __forceinline__ void kload8(h16x8* kf, lds_cptr kp) {
    kf[0] = *(const __attribute__((address_space(3))) h16x8*)(kp);        kf[1] = *(const __attribute__((address_space(3))) h16x8*)(kp + 512);
    kf[2] = *(const __attribute__((address_space(3))) h16x8*)(kp + 2048); kf[3] = *(const __attribute__((address_space(3))) h16x8*)(kp + 2560);
    kf[4] = *(const __attribute__((address_space(3))) h16x8*)(kp + 4096); kf[5] = *(const __attribute__((address_space(3))) h16x8*)(kp + 4608);
    kf[6] = *(const __attribute__((address_space(3))) h16x8*)(kp + 6144); kf[7] = *(const __attribute__((address_space(3))) h16x8*)(kp + 6656);
}
__device__ __forceinline__ void kload2(h16x8* kf, lds_cptr kp, int j) { kf[2 * j] = *(const __attribute__((address_space(3))) h16x8*)(kp + j * 2048); kf[2 * j + 1] = *(const __attribute__((address_space(3))) h16x8*)(kp + j * 2048 + 512); }
__device__ __forceinline__ s16x4 vtr(lds_cptr p) { return __builtin_bit_cast(s16x4, __builtin_amdgcn_ds_read_tr16_b64_v4i16((__attribute__((address_space(3))) v4i16_t*)p)); }
__device__ __forceinline__ void pv(f32x16* o, int vb, h16x8 pa0, h16x8 pa1, h16x8 pa2, h16x8 pa3) {
#pragma unroll
    for (int d0 = 0; d0 < 4; ++d0) { s16x4 lo[4], hi[4];
#pragma unroll
        for (int ks = 0; ks < 4; ++ks) {
            asm volatile("ds_read_b64_tr_b16 %0,%1 offset:%c2" : "=&v"(lo[ks]) : "v"(vb), "i"(d0 * 4096 + ks * 1024) : "memory");
            asm volatile("ds_read_b64_tr_b16 %0,%1 offset:%c2" : "=&v"(hi[ks]) : "v"(vb), "i"(d0 * 4096 + ks * 1024 + 512) : "memory"); }
        asm volatile("s_waitcnt lgkmcnt(0)" ::: "memory"); FD_SBAR();
#define FD_PK(k) __builtin_bit_cast(h16x8, (short __attribute__((ext_vector_type(8)))){lo[k][0], lo[k][1], lo[k][2], lo[k][3], hi[k][0], hi[k][1], hi[k][2], hi[k][3]})
        o[d0] = __builtin_amdgcn_mfma_f32_32x32x16_f16(pa0, FD_PK(0), o[d0], 0, 0, 0);
        o[d0] = __builtin_amdgcn_mfma_f32_32x32x16_f16(pa1, FD_PK(1), o[d0], 0, 0, 0);
        o[d0] = __builtin_amdgcn_mfma_f32_32x32x16_f16(pa2, FD_PK(2), o[d0], 0, 0, 0);
        o[d0] = __builtin_amdgcn_mfma_f32_32x32x16_f16(pa3, FD_PK(3), o[d0], 0, 0, 0);
#undef FD_PK
    }
}
__device__ __forceinline__ char* ptab_abs(int i) { const volatile LAS unsigned* t = (const volatile LAS unsigned*)(LDS_PTAB) + 2 * i; const unsigned lo = __builtin_amdgcn_readfirstlane(t[0]), hi = __builtin_amdgcn_readfirstlane(t[1]);
    return (char*)(__attribute__((address_space(1))) char*)(((unsigned long long)hi << 32) | (unsigned long long)lo); }
template <int THRL>
__device__ __forceinline__ void attn_unit(int qoff, int koff, int voff, int ooff, int roff, int q0, char* shm, int epi, float lam) {
    const int tid = tid_fresh(), lane = tid & 63, r32 = lane & 31, hi = lane >> 5; const int wid = __builtin_amdgcn_readfirstlane(tid >> 6);
    const unsigned lds0 = (unsigned)(uintptr_t)shm;
    float* wsf = (float*)(shm + LDS_WS) + wid * 64;
    const h16* PROJp = (const h16*)(ptab_abs(34) + WS_PROJ);
    const h16* ksrc = PROJp + koff + (size_t)lane * NPROJ + wid * 8;
    const h16* vsrc = PROJp + voff + (size_t)(16 * (wid & 3) + (lane >> 2)) * NPROJ + (wid >> 2) * 32 + (lane & 3) * 8;
    const unsigned kdst = lds0 + LDS_K + wid * 1024, vdst = lds0 + LDS_V + wid * 1024;
#define FD_DMA_K(t, slot) glds16(ksrc + (size_t)(t) * 64 * NPROJ, (unsigned)__builtin_amdgcn_readfirstlane(kdst + (slot)))
#define FD_DMA_V(t, slot) do { glds16(vsrc + (size_t)(t) * 64 * NPROJ, (unsigned)__builtin_amdgcn_readfirstlane(vdst + (slot))); \
                               glds16(vsrc + (size_t)(t) * 64 * NPROJ + 64, (unsigned)__builtin_amdgcn_readfirstlane(vdst + (slot) + 8192)); } while (0)
    const int vb0 = (int)(lds0 + LDS_V) + ((lane >> 4) & 1) * 32 + (lane & 3) * 8 + (4 * hi + ((lane & 15) >> 2)) * 64;
    const char* Kbase = shm + LDS_K; h16x8 kf[8];
    const lds_cptr shm3 = (lds_cptr)shm; const lds_cptr kp0 = shm3 + LDS_K + hi * 1024 + r32 * 16;
    const lds_cptr vp0 = shm3 + LDS_V + ((lane >> 4) & 1) * 32 + (lane & 3) * 8 + (4 * hi + ((lane & 15) >> 2)) * 64;
    const int NT = (q0 + 256) / 64;
    FD_DMA_K(0, 0); FD_DMA_V(0, 0); FD_DMA_K(1, KSLOT);
    h16x8 qr[4];
    { const h16* Qw = PROJp + qoff + (size_t)(wid * 32 + r32) * NPROJ + hi * 8;
#pragma unroll
      for (int d0 = 0; d0 < 4; ++d0) qr[d0] = *reinterpret_cast<const h16x8*>(Qw + d0 * 16);
      const float* cr = (const float*)(ptab_abs(34) + WS_ROPE) + (size_t)(roff + wid * 32 + r32) * 8 + 4 * hi; const f32x4 c4 = *(const f32x4*)cr, s4 = *(const f32x4*)(cr + (size_t)T * 8);
#pragma unroll
      for (int j = 0; j < 4; ++j) { const float x1 = (float)qr[0][j], x2 = (float)qr[0][4 + j]; qr[0][j] = (h16)((x1 * c4[j] - x2 * s4[j]) * C2); qr[0][4 + j] = (h16)((x2 * c4[j] + x1 * s4[j]) * C2); }
#pragma unroll
      for (int d0 = 1; d0 < 4; ++d0)
#pragma unroll
          for (int j = 0; j < 8; ++j) qr[d0][j] = (h16)((float)qr[d0][j] * C2); }
    float mhat = 0.f, l_reg = 0.f; f32x16 o[4]; o[0] = f32x16{}; o[1] = f32x16{}; o[2] = f32x16{}; o[3] = f32x16{}; f32x16 negm = f32x16{}; asm volatile("" : "+v"(negm));
    const int qrel = wid * 32 + r32;
#define FD_CMASK(P0, P1, t) do { int jb_ = (t) - (NT - 4); if (jb_ >= 0) fa::cmask(P0, P1, 64 * jb_, qrel, hi); } while (0)
    bool resc = false;
#define FD_START(P0, P1) do { mhat = rowmax_(P0, P1); resc = false; \
    _Pragma("unroll") for (int r = 0; r < 16; ++r) { P0[r] = fsub_s(P0[r], mhat); P1[r] = fsub_s(P1[r], mhat); } \
    _Pragma("unroll") for (int r = 0; r < 16; ++r) negm[r] = -mhat; asm volatile("" : "+v"(negm)); \
    _Pragma("unroll") for (int r = 0; r < 16; ++r) P0[r] = __builtin_amdgcn_exp2f(P0[r]); } while (0)
#define FD_RESC() do { if (resc) { asm volatile("s_waitcnt lgkmcnt(0)" ::: "memory"); \
      _Pragma("unroll") for (int d_ = 0; d_ < 4; ++d_) _Pragma("unroll") for (int r = 0; r < 16; ++r) o[d_][r] *= wsf[crow(r, hi)]; } } while (0)
    auto rowmax_ = [&](const f32x16& p0, const f32x16& p1) -> float {
        float a = max3f(p0[0], p0[1], p1[0]), b = max3f(p0[2], p0[3], p1[1]); a = max3f(a, p1[2], p1[3]);
#pragma unroll
        for (int r = 4; r < 16; r += 4) { a = max3f(a, p0[r], p0[r + 1]); b = max3f(b, p0[r + 2], p0[r + 3]); a = max3f(a, p1[r], p1[r + 1]); b = max3f(b, p1[r + 2], p1[r + 3]); }
        const float m = max2f(a, b);
        auto rr = __builtin_amdgcn_permlane32_swap(__float_as_uint(m), __float_as_uint(m), false, false);
        return max2f(__uint_as_float(rr[0]), __uint_as_float(rr[1])); };
    f32x16 pA0, pA1, pB0, pB1;
    int sl_prev = 0, sl_cur = 0, sl_next = VSLOT;
#define FD_ROT() do { sl_prev = sl_cur; sl_cur = sl_next; sl_next = (sl_next == (NSLV - 1) * VSLOT) ? 0 : sl_next + VSLOT; } while (0)
#define FD_KS(t) (((t) & 3) * KSLOT)
    FD_DMA_K(2, 2 * KSLOT);
    FD_WAIT_BAR(4);
    qkt(pA0, pA1, Kbase, qr, r32, hi); asm volatile("s_nop 15\n\ts_nop 7" : "+v"(pA0), "+v"(pA1)); FD_CMASK(pA0, pA1, 0);
    FD_START(pA0, pA1);
#pragma unroll
    for (int r = 0; r < 16; ++r) pA1[r] = __builtin_amdgcn_exp2f(pA1[r]);
    FD_WAIT_BAR(0);
    FD_DMA_K(3, 3 * KSLOT); FD_DMA_V(1, VSLOT);
    FD_ROT();
    kload2(kf, kp0 + KSLOT, 0); kload2(kf, kp0 + KSLOT, 1);
    FD_WAIT_BAR(3);
    s16x4 vlo[16], vhi[16]; u32x4 pw0, pw1, pw2, pw3;
#define FD_PKW(P, B) cvtpk_s(P[B], P[B + 1])
#define FD_PAF(k) __builtin_bit_cast(h16x8, pw##k)
#define FD_VFR(i) __builtin_bit_cast(h16x8, (short __attribute__((ext_vector_type(8)))){vlo[i][0], vlo[i][1], vlo[i][2], vlo[i][3], vhi[i][0], vhi[i][1], vhi[i][2], vhi[i][3]})
#define FD_PIN(x) asm volatile("" : "+v"(x))
#define FD_MX3(a, b, c) __builtin_fmaxf(__builtin_fmaxf((a), (b)), (c))
#define FD_GAPA(MF, A0, A1, A2, A3, W0, W1, PW) do { MF; sacc += A0; sacc += A1; sacc += A2; sacc += A3; FD_PIN(sacc); W0; W1; FD_PIN(PW); FD_SBAR(); } while (0)
#define FD_EX(v) __builtin_amdgcn_exp2f(v)
#define FD_GAPB(MF, X, B) do { MF; X[B] = FD_EX(X[B]); X[B + 1] = FD_EX(X[B + 1]); FD_PIN(X); FD_SBAR(); } while (0)
#define FD_VRD(g) do { vlo[g] = vtr(vp_ + (((g) & 3) * 4096 + ((g) >> 2) * 1024)); vhi[g] = vtr(vp_ + (((g) & 3) * 4096 + ((g) >> 2) * 1024 + 512)); } while (0)
#define FD_KRD(G, j, t) do { if (G) { kload2(kf, kp0 + FD_KS((t) + 1), j); FD_SBAR(); } } while (0)
#define FD_KR1(i, t) do { kf[i] = *(const __attribute__((address_space(3))) h16x8*)(kp0 + FD_KS(t) + ((i) >> 1) * 2048 + ((i) & 1) * 512); FD_SBAR(); } while (0)
#define FD_PVM(g, ks) o[(g) & 3] = __builtin_amdgcn_mfma_f32_32x32x16_f16(FD_PAF(ks), FD_VFR(g), o[(g) & 3], 0, 0, 0)
#define FD_STEP(C0, C1, P0, P1, t, GK, GV, GL) do { FD_SBAR(); \
    const lds_cptr vp_ = vp0 + sl_prev; \
    float sacc = (P0[0] + P0[1]); \
    FD_KR1(4, t); FD_GAPA(C0 = __builtin_amdgcn_mfma_f32_32x32x16_f16(kf[0], qr[0], negm, 0, 0, 0), P0[2], P0[3], P0[4], P0[5],     pw0[0] = FD_PKW(P0, 0), pw0[1] = FD_PKW(P0, 2), pw0); \
    FD_KR1(5, t); FD_GAPA(C1 = __builtin_amdgcn_mfma_f32_32x32x16_f16(kf[1], qr[0], negm, 0, 0, 0), P0[6], P0[7], P0[8], P0[9],     pw0[2] = FD_PKW(P0, 4), pw0[3] = FD_PKW(P0, 6), pw0); \
    FD_KR1(6, t); FD_GAPA(C0 = __builtin_amdgcn_mfma_f32_32x32x16_f16(kf[2], qr[1], C0, 0, 0, 0),   P0[10], P0[11], P0[12], P0[13], pw1[0] = FD_PKW(P0, 8), pw1[1] = FD_PKW(P0, 10), pw1); \
    FD_KR1(7, t); FD_GAPA(C1 = __builtin_amdgcn_mfma_f32_32x32x16_f16(kf[3], qr[1], C1, 0, 0, 0),   P0[14], P0[15], P1[0], P1[1],   pw1[2] = FD_PKW(P0, 12), pw1[3] = FD_PKW(P0, 14), pw1); \
    FD_VRD(0); FD_SBAR(); FD_GAPA(C0 = __builtin_amdgcn_mfma_f32_32x32x16_f16(kf[4], qr[2], C0, 0, 0, 0),   P1[2], P1[3], P1[4], P1[5],     pw2[0] = FD_PKW(P1, 0), pw2[1] = FD_PKW(P1, 2), pw2); \
    FD_VRD(1); FD_SBAR(); FD_GAPA(C1 = __builtin_amdgcn_mfma_f32_32x32x16_f16(kf[5], qr[2], C1, 0, 0, 0),   P1[6], P1[7], P1[8], P1[9],     pw2[2] = FD_PKW(P1, 4), pw2[3] = FD_PKW(P1, 6), pw2); \
    FD_VRD(2); FD_SBAR(); FD_GAPA(C0 = __builtin_amdgcn_mfma_f32_32x32x16_f16(kf[6], qr[3], C0, 0, 0, 0),   P1[10], P1[11], P1[12], P1[13], pw3[0] = FD_PKW(P1, 8), pw3[1] = FD_PKW(P1, 10), pw3); \
    FD_VRD(3); FD_SBAR(); FD_GAPA(C1 = __builtin_amdgcn_mfma_f32_32x32x16_f16(kf[7], qr[3], C1, 0, 0, 0),   P1[14], P1[15], 0.f, 0.f,       pw3[2] = FD_PKW(P1, 12), pw3[3] = FD_PKW(P1, 14), pw3); \
    l_reg += sacc; \
    if (GK) { FD_DMA_K((t) + 3, FD_KS((t) + 3)); } if (GV) { FD_DMA_V((t) + 1, sl_next); } \
    FD_CMASK(C0, C1, t); \
    { float a = FD_MX3(C0[0], C0[1], C1[0]), b = FD_MX3(C0[2], C0[3], C1[1]); a = FD_MX3(a, C1[2], C1[3]); \
      _Pragma("unroll") for (int r = 4; r < 16; r += 4) { a = FD_MX3(a, C0[r], C0[r + 1]); b = FD_MX3(b, C0[r + 2], C0[r + 3]); a = FD_MX3(a, C1[r], C1[r + 1]); b = FD_MX3(b, C1[r + 2], C1[r + 3]); } \
      float rm = __builtin_fmaxf(a, b); { auto rr = __builtin_amdgcn_permlane32_swap(__float_as_uint(rm), __float_as_uint(rm), false, false); rm = __builtin_fmaxf(__uint_as_float(rr[0]), __uint_as_float(rr[1])); } \
      resc = false; \
      if (__builtin_expect(__any(rm > (float)THRL), 0)) { const float dl = __builtin_fmaxf(rm, 0.f); mhat += dl; \
        _Pragma("unroll") for (int r = 0; r < 16; ++r) { C0[r] -= dl; C1[r] -= dl; } \
        _Pragma("unroll") for (int r = 0; r < 16; ++r) negm[r] = -mhat; asm volatile("" : "+v"(negm)); \
        const float f = __builtin_amdgcn_exp2f(-dl); l_reg *= f; if (hi == 0) wsf[r32] = f; resc = true; } } \
    FD_SBAR(); \
    FD_GAPB(FD_PVM(0, 0), C0, 0);   FD_VRD(4);  FD_SBAR(); \
    FD_GAPB(FD_PVM(1, 0), C0, 2);   FD_VRD(5);  FD_SBAR(); \
    FD_GAPB(FD_PVM(2, 0), C0, 4);   FD_VRD(6);  FD_SBAR(); \
    FD_GAPB(FD_PVM(3, 0), C0, 6);   FD_VRD(7);  FD_SBAR(); \
    FD_GAPB(FD_PVM(4, 1), C0, 8);   FD_VRD(8);  FD_SBAR(); \
    FD_GAPB(FD_PVM(5, 1), C0, 10);  FD_VRD(9);  FD_SBAR(); \
    FD_GAPB(FD_PVM(6, 1), C0, 12);  FD_VRD(10); FD_SBAR(); \
    FD_GAPB(FD_PVM(7, 1), C0, 14);  FD_VRD(11); FD_SBAR(); \
    FD_GAPB(FD_PVM(8, 2), C1, 0);   FD_VRD(12); FD_SBAR(); \
    FD_GAPB(FD_PVM(9, 2), C1, 2);   FD_VRD(13); FD_SBAR(); \
    FD_GAPB(FD_PVM(10, 2), C1, 4);  FD_VRD(14); FD_SBAR(); \
    FD_GAPB(FD_PVM(11, 2), C1, 6);  FD_VRD(15); FD_SBAR(); \
    FD_KRD(GL, 0, t); FD_GAPB(FD_PVM(12, 3), C1, 8); \
    FD_KRD(GL, 1, t); FD_GAPB(FD_PVM(13, 3), C1, 10); \
    FD_GAPB(FD_PVM(14, 3), C1, 12); \
    FD_GAPB(FD_PVM(15, 3), C1, 14); \
    } while (0)
    int t = 1;
#undef FD_CMASK
#define FD_CMASK(P0, P1, t) do { } while (0)
    for (; t + 5 < NT; t += 2) {
        FD_STEP(pB0, pB1, pA0, pA1, t, true, true, true);     FD_WAIT_BAR(3); FD_RESC(); FD_ROT();
        FD_STEP(pA0, pA1, pB0, pB1, t + 1, true, true, true); FD_WAIT_BAR(3); FD_RESC(); FD_ROT();
    }
#undef FD_CMASK
#define FD_CMASK(P0, P1, t) do { int jb_ = (t) - (NT - 4); if (jb_ >= 0) fa::cmask(P0, P1, 64 * jb_, qrel, hi); } while (0)
#define FD_ENDW(tt) do { if ((tt) + 3 < NT) { FD_WAIT_BAR(3); } else if ((tt) + 2 < NT) { FD_WAIT_BAR(2); } else { FD_WAIT_BAR(0); } } while (0)
    for (; t + 1 < NT; t += 2) {
        FD_STEP(pB0, pB1, pA0, pA1, t, (t + 3 < NT), (t + 1 < NT), (t + 1 < NT));         FD_ENDW(t);     FD_RESC(); FD_ROT();
        FD_STEP(pA0, pA1, pB0, pB1, t + 1, (t + 4 < NT), (t + 2 < NT), (t + 2 < NT));     FD_ENDW(t + 1); FD_RESC(); FD_ROT();
    }
    FD_STEP(pB0, pB1, pA0, pA1, NT - 1, false, false, false); FD_RESC();
    { float sacc = pB0[0] + pB0[1];
#pragma unroll
      for (int r = 2; r < 16; ++r) sacc += pB0[r];
#pragma unroll
      for (int r = 0; r < 16; ++r) sacc += pB1[r];
      l_reg += sacc;
      pw0 = (u32x4){FD_PKW(pB0, 0), FD_PKW(pB0, 2), FD_PKW(pB0, 4), FD_PKW(pB0, 6)}; pw1 = (u32x4){FD_PKW(pB0, 8), FD_PKW(pB0, 10), FD_PKW(pB0, 12), FD_PKW(pB0, 14)};
      pw2 = (u32x4){FD_PKW(pB1, 0), FD_PKW(pB1, 2), FD_PKW(pB1, 4), FD_PKW(pB1, 6)}; pw3 = (u32x4){FD_PKW(pB1, 8), FD_PKW(pB1, 10), FD_PKW(pB1, 12), FD_PKW(pB1, 14)};
      FD_SBAR(); pv(o, vb0 + sl_cur, FD_PAF(0), FD_PAF(1), FD_PAF(2), FD_PAF(3)); }
    { auto rr = __builtin_amdgcn_permlane32_swap(__float_as_uint(l_reg), __float_as_uint(l_reg), false, false); l_reg = __uint_as_float(rr[0]) + __uint_as_float(rr[1]); }
    if (hi == 0) wsf[32 + r32] = l_reg; asm volatile("s_waitcnt lgkmcnt(0)" ::: "memory");
    float rli[16];
#pragma unroll
    for (int r = 0; r < 16; ++r) rli[r] = __builtin_amdgcn_rcpf(wsf[32 + crow(r, hi)]);
    if (epi) asm volatile("s_waitcnt lgkmcnt(0)\n\ts_barrier" ::: "memory");
    char* stg = shm + (epi ? 0 : LDS_STASH) + wid * (32 * 272);
#pragma unroll
    for (int r = 0; r < 16; ++r) { const int orow = crow(r, hi);
#pragma unroll
        for (int d0 = 0; d0 < 4; ++d0) *(h16*)(stg + orow * 272 + (d0 * 32 + r32) * 2) = (h16)(o[d0][r] * rli[r]); }
    asm volatile("s_waitcnt lgkmcnt(0)" ::: "memory");
    if (epi) {
        h16* Ow = (h16*)(ptab_abs(34) + WS_MIX) + ooff + (size_t)(wid * 32) * 1024; const int ch = lane & 15;
        const f32x8 g8v = *(const f32x8*)((const float*)ptab_abs(8) + ch * 8);
#pragma unroll
        for (int i = 0; i < 8; ++i) { const int row = i * 4 + (lane >> 4);
            const h16x8 a = *(const h16x8*)(stg + row * 272 + ch * 16); const h16x8 a1 = *(const h16x8*)(shm + LDS_STASH + wid * (32 * 272) + row * 272 + ch * 16); float v[8];
#pragma unroll
            for (int e = 0; e < 8; ++e) v[e] = (float)a1[e] - lam * (float)a[e];
            float ss = 0.f;
#pragma unroll
            for (int e = 0; e < 8; ++e) ss += v[e] * v[e];
            ss += shx(ss, 1); ss += shx(ss, 2); ss += shx(ss, 4); ss += shx(ss, 8);
            const float rs = rsqrtf(ss * (1.f / 128.f) + RMS_EPS) * 0.8f; h16x8 ov;
#pragma unroll
            for (int e = 0; e < 8; ++e) ov[e] = (h16)(v[e] * rs * g8v[e]);
            *(h16x8*)(Ow + (size_t)row * 1024 + ch * 8) = ov; }
    }
    asm volatile("s_waitcnt lgkmcnt(0)\n\ts_barrier" ::: "memory");
#undef FD_DMA_K
#undef FD_DMA_V
#undef FD_CMASK
#undef FD_START
#undef FD_RESC
#undef FD_ROT
#undef FD_PKW
#undef FD_PAF
#undef FD_VFR
#undef FD_PIN
#undef FD_MX3
#undef FD_GAPA
#undef FD_GAPB
#undef FD_EX
#undef FD_VRD
#undef FD_KRD
#undef FD_KR1
#undef FD_KS
#undef FD_PVM
#undef FD_STEP
#undef FD_ENDW
}
#undef FD_SBAR
#undef FD_WAIT_BAR
}
namespace fm {
using fd::s16x4; using fd::u32x4; using fd::lds_cptr; using fd::v4i16_t;
#define FM_SBAR() __builtin_amdgcn_sched_barrier(0)
constexpr int KSLOT = 24576, VSLOT = 16384;
constexpr int LDS_K = 0, LDS_V = 3 * KSLOT, LDS_WS = LDS_V + 3 * VSLOT, LDS_Q = LDS_WS + 2048, LDS_END = LDS_Q + 8 * 4096;
static_assert(LDS_END <= LDS_BYTES - 1024, "fm LDS map");
constexpr float C2 = 0.07216878364870322f * LOG2E;
#define FM_WAIT_BAR(N) asm volatile("s_waitcnt vmcnt(" #N ") lgkmcnt(0)\n\ts_barrier" ::: "memory")
typedef const __attribute__((address_space(3))) h16x8* lds_h8;
template <int THRL>
__device__ __forceinline__ void attn_unit(int t0, int h, int q0, char* shm) {
    const int tid = tid_fresh(), lane = tid & 63, r32 = lane & 31, hi = lane >> 5; const int wid = __builtin_amdgcn_readfirstlane(tid >> 6);
    const unsigned lds0 = (unsigned)(uintptr_t)shm;
    float* wsf = (float*)(shm + LDS_WS) + wid * 64;
    const h16* QKVMp = (const h16*)(fd::ptab_abs(34) + WS_QKVM); const h16* PROJp = (const h16*)(fd::ptab_abs(34) + WS_PROJ);
    const h16* ksrcn = QKVMp + (size_t)t0 * NUP + 768 + h * 256 + (size_t)lane * NUP + wid * 8;
    const h16* ksrcr = PROJp + (size_t)t0 * NPROJ + C_KR + (size_t)lane * NPROJ + wid * 8;
    const h16* vsrc = QKVMp + (size_t)t0 * NUP + 768 + h * 256 + 128 + (size_t)(16 * (wid & 3) + (lane >> 2)) * NUP + (wid >> 2) * 32 + (lane & 3) * 8;
    const unsigned kdst = lds0 + LDS_K + wid * 1024, vdst = lds0 + LDS_V + wid * 1024;
#define FM_DMA_K(t, koff) do { const unsigned d_ = (unsigned)__builtin_amdgcn_readfirstlane(kdst + (koff)); \
        fd::glds16(ksrcn + (size_t)(t) * 64 * NUP, d_); fd::glds16(ksrcn + (size_t)(t) * 64 * NUP + 64, d_ + 8192); fd::glds16(ksrcr + (size_t)(t) * 64 * NPROJ, d_ + 16384); } while (0)
#define FM_DMA_V(t, voff) do { const unsigned d_ = (unsigned)__builtin_amdgcn_readfirstlane(vdst + (voff)); \
        fd::glds16(vsrc + (size_t)(t) * 64 * NUP, d_); fd::glds16(vsrc + (size_t)(t) * 64 * NUP + 64, d_ + 8192); } while (0)
    const int vb0 = (int)(lds0 + LDS_V) + ((lane >> 4) & 1) * 32 + (lane & 3) * 8 + (4 * hi + ((lane & 15) >> 2)) * 64;
    const lds_cptr shm3 = (lds_cptr)shm; const lds_cptr kp0 = shm3 + LDS_K + hi * 1024 + r32 * 16;
    const lds_cptr vp0 = shm3 + LDS_V + ((lane >> 4) & 1) * 32 + (lane & 3) * 8 + (4 * hi + ((lane & 15) >> 2)) * 64;
    const lds_cptr qp0 = shm3 + LDS_Q + wid * 4096 + lane * 16;
    const int NT = (q0 + 256) / 64;
    FM_DMA_K(0, 0); FM_DMA_V(0, 0); FM_DMA_K(1, KSLOT); FM_DMA_K(2, 2 * KSLOT);
    h16x8 qr[8];
    { const h16* Qw = QKVMp + (size_t)(t0 + q0 + wid * 32 + r32) * NUP + h * 192 + hi * 8; h16x8 qt[4];
#pragma unroll
      for (int d0 = 0; d0 < 8; ++d0) qr[d0] = *reinterpret_cast<const h16x8*>(Qw + d0 * 16);
#pragma unroll
      for (int d0 = 0; d0 < 4; ++d0) qt[d0] = *reinterpret_cast<const h16x8*>(Qw + (8 + d0) * 16);
      const float* cr = (const float*)(fd::ptab_abs(34) + WS_ROPE) + (size_t)T * 16 + (size_t)(t0 + q0 + wid * 32 + r32) * 32 + 8 * hi; const float* sr_ = cr + (size_t)T * 32;
#pragma unroll
      for (int blk = 0; blk < 2; ++blk) { const f32x8 c8 = *(const f32x8*)(cr + 16 * blk), s8 = *(const f32x8*)(sr_ + 16 * blk);
#pragma unroll
          for (int j = 0; j < 8; ++j) { const float x1 = (float)qt[blk][j], x2 = (float)qt[2 + blk][j];
              qt[blk][j] = (h16)((x1 * c8[j] - x2 * s8[j]) * C2); qt[2 + blk][j] = (h16)((x2 * c8[j] + x1 * s8[j]) * C2); } }
#pragma unroll
      for (int d0 = 0; d0 < 8; ++d0)
#pragma unroll
          for (int j = 0; j < 8; ++j) qr[d0][j] = (h16)((float)qr[d0][j] * C2);
#pragma unroll
      for (int d0 = 0; d0 < 4; ++d0) *(h16x8*)(shm + LDS_Q + wid * 4096 + lane * 16 + d0 * 1024) = qt[d0]; }
    float mhat = 0.f, l_reg = 0.f; f32x16 o[4]; o[0] = f32x16{}; o[1] = f32x16{}; o[2] = f32x16{}; o[3] = f32x16{}; const f32x16 zero16 = f32x16{};
    const int qrel = wid * 32 + r32;
#define FM_CMASK(P0, P1, t) do { int jb_ = (t) - (NT - 4); if (jb_ >= 0) fa::cmask(P0, P1, 64 * jb_, qrel, hi); } while (0)
    bool resc = false;
#define FM_RESC() do { if (resc) { asm volatile("s_waitcnt lgkmcnt(0)" ::: "memory"); \
      _Pragma("unroll") for (int d_ = 0; d_ < 4; ++d_) _Pragma("unroll") for (int r = 0; r < 16; ++r) o[d_][r] *= wsf[crow(r, hi)]; } } while (0)
    f32x16 pA0, pA1, pB0, pB1;
    int sl_prev = 0, sl_cur = 0, sl_next = VSLOT;
#define FM_ROT() do { sl_prev = sl_cur; sl_cur = sl_next; sl_next = (sl_next == 2 * VSLOT) ? 0 : sl_next + VSLOT; } while (0)
#define FM_KO(v) ((v) + ((v) >> 1))
    FM_WAIT_BAR(0);
    { pA0 = zero16; pA1 = zero16; const char* kb = shm + LDS_K + hi * 1024 + r32 * 16;
#pragma unroll
      for (int d0 = 0; d0 < 12; ++d0) { const h16x8 b0 = *reinterpret_cast<const h16x8*>(kb + d0 * 2048), b1 = *reinterpret_cast<const h16x8*>(kb + d0 * 2048 + 512);
          const h16x8 qf = d0 < 8 ? qr[d0 < 8 ? d0 : 0] : *reinterpret_cast<const h16x8*>(shm + LDS_Q + wid * 4096 + lane * 16 + (d0 - 8) * 1024);
          pA0 = __builtin_amdgcn_mfma_f32_32x32x16_f16(b0, qf, pA0, 0, 0, 0); pA1 = __builtin_amdgcn_mfma_f32_32x32x16_f16(b1, qf, pA1, 0, 0, 0); } }
    asm volatile("s_nop 15\n\ts_nop 7" : "+v"(pA0), "+v"(pA1)); FM_CMASK(pA0, pA1, 0);
    { float a = fd::max3f(pA0[0], pA0[1], pA1[0]), b = fd::max3f(pA0[2], pA0[3], pA1[1]); a = fd::max3f(a, pA1[2], pA1[3]);
#pragma unroll
      for (int r = 4; r < 16; r += 4) { a = fd::max3f(a, pA0[r], pA0[r + 1]); b = fd::max3f(b, pA0[r + 2], pA0[r + 3]); a = fd::max3f(a, pA1[r], pA1[r + 1]); b = fd::max3f(b, pA1[r + 2], pA1[r + 3]); }
      const float m = fd::max2f(a, b); auto rr = __builtin_amdgcn_permlane32_swap(__float_as_uint(m), __float_as_uint(m), false, false);
      mhat = fd::max2f(__uint_as_float(rr[0]), __uint_as_float(rr[1])); }
#pragma unroll
    for (int r = 0; r < 16; ++r) { pA0[r] = __builtin_amdgcn_exp2f(fd::fsub_s(pA0[r], mhat)); pA1[r] = __builtin_amdgcn_exp2f(fd::fsub_s(pA1[r], mhat)); }
    FM_WAIT_BAR(0);
    FM_DMA_V(1, VSLOT);
    FM_ROT();
    h16x8 kf[24]; h16x8 ql[4];
    kf[0] = *(lds_h8)(kp0 + KSLOT); kf[1] = *(lds_h8)(kp0 + KSLOT + 512); kf[2] = *(lds_h8)(kp0 + KSLOT + 2048); kf[3] = *(lds_h8)(kp0 + KSLOT + 2560);
    kf[4] = *(lds_h8)(kp0 + KSLOT + 4096); kf[5] = *(lds_h8)(kp0 + KSLOT + 4608);
    FM_WAIT_BAR(2);
    s16x4 vlo[16], vhi[16]; u32x4 pw0, pw1, pw2, pw3;
#define FM_PKW(P, B) fd::cvtpk_s(P[B], P[B + 1])
#define FM_PAF(k) __builtin_bit_cast(h16x8, pw##k)
#define FM_VFR(i) __builtin_bit_cast(h16x8, (short __attribute__((ext_vector_type(8)))){vlo[i][0], vlo[i][1], vlo[i][2], vlo[i][3], vhi[i][0], vhi[i][1], vhi[i][2], vhi[i][3]})
#define FM_PIN(x) asm volatile("" : "+v"(x))
#define FM_MX3(a, b, c) __builtin_fmaxf(__builtin_fmaxf((a), (b)), (c))
#define FM_EX(v) __builtin_amdgcn_exp2f(v)
#define FM_GAPB(MF, X, B) do { MF; X[B] = FM_EX(X[B] - mhat); X[B + 1] = FM_EX(X[B + 1] - mhat); FM_PIN(X); FM_SBAR(); } while (0)
#define FM_VRD(g) do { vlo[g] = fd::vtr(vp_ + (((g) & 3) * 4096 + ((g) >> 2) * 1024)); vhi[g] = fd::vtr(vp_ + (((g) & 3) * 4096 + ((g) >> 2) * 1024 + 512)); } while (0)
#define FM_KR(i, ko) do { kf[i] = *(lds_h8)(kp0 + (ko) + ((i) >> 1) * 2048 + ((i) & 1) * 512); } while (0)
#define FM_QL(d) do { ql[(d) - 8] = *(lds_h8)(qp0 + ((d) - 8) * 1024); } while (0)
#define FM_PVM(g, ks) o[(g) & 3] = __builtin_amdgcn_mfma_f32_32x32x16_f16(FM_PAF(ks), FM_VFR(g), o[(g) & 3], 0, 0, 0)
#define FM_STEP(C0, C1, P0, P1, t, GK, GV, GL) do { FM_SBAR(); \
    if (GK) { FM_DMA_K((t) + 2, FM_KO(sl_prev)); } if (GV) { FM_DMA_V((t) + 1, sl_next); } \
    const lds_cptr vp_ = vp0 + sl_prev; const int kc_ = FM_KO(sl_cur); \
    float sacc = 0.f; \
    FM_KR(6, kc_); FM_SBAR(); C0 = __builtin_amdgcn_mfma_f32_32x32x16_f16(kf[0], qr[0], zero16, 0, 0, 0); sacc += P0[0]; sacc += P0[1]; FM_PIN(sacc); pw0[0] = FM_PKW(P0, 0); FM_PIN(pw0); FM_SBAR(); \
    FM_KR(7, kc_); FM_SBAR(); C1 = __builtin_amdgcn_mfma_f32_32x32x16_f16(kf[1], qr[0], zero16, 0, 0, 0); sacc += P0[2]; sacc += P0[3]; FM_PIN(sacc); pw0[1] = FM_PKW(P0, 2); FM_PIN(pw0); FM_SBAR(); \
    FM_KR(8, kc_); FM_SBAR(); C0 = __builtin_amdgcn_mfma_f32_32x32x16_f16(kf[2], qr[1], C0, 0, 0, 0); sacc += P0[4]; sacc += P0[5]; FM_PIN(sacc); pw0[2] = FM_PKW(P0, 4); FM_PIN(pw0); FM_SBAR(); \
    FM_KR(9, kc_); FM_SBAR(); C1 = __builtin_amdgcn_mfma_f32_32x32x16_f16(kf[3], qr[1], C1, 0, 0, 0); sacc += P0[6]; sacc += P0[7]; FM_PIN(sacc); pw0[3] = FM_PKW(P0, 6); FM_PIN(pw0); FM_SBAR(); \
    FM_KR(10, kc_); FM_SBAR(); C0 = __builtin_amdgcn_mfma_f32_32x32x16_f16(kf[4], qr[2], C0, 0, 0, 0); sacc += P0[8]; sacc += P0[9]; FM_PIN(sacc); pw1[0] = FM_PKW(P0, 8); FM_PIN(pw1); FM_SBAR(); \
    FM_KR(11, kc_); FM_SBAR(); C1 = __builtin_amdgcn_mfma_f32_32x32x16_f16(kf[5], qr[2], C1, 0, 0, 0); sacc += P0[10]; sacc += P0[11]; FM_PIN(sacc); pw1[1] = FM_PKW(P0, 10); FM_PIN(pw1); FM_SBAR(); \
    FM_KR(12, kc_); FM_SBAR(); C0 = __builtin_amdgcn_mfma_f32_32x32x16_f16(kf[6], qr[3], C0, 0, 0, 0); sacc += P0[12]; sacc += P0[13]; FM_PIN(sacc); pw1[2] = FM_PKW(P0, 12); FM_PIN(pw1); FM_SBAR(); \
    FM_KR(13, kc_); FM_SBAR(); C1 = __builtin_amdgcn_mfma_f32_32x32x16_f16(kf[7], qr[3], C1, 0, 0, 0); sacc += P0[14]; sacc += P0[15]; FM_PIN(sacc); pw1[3] = FM_PKW(P0, 14); FM_PIN(pw1); FM_SBAR(); \
    FM_KR(14, kc_); FM_SBAR(); C0 = __builtin_amdgcn_mfma_f32_32x32x16_f16(kf[8], qr[4], C0, 0, 0, 0); sacc += P1[0]; sacc += P1[1]; FM_PIN(sacc); pw2[0] = FM_PKW(P1, 0); FM_PIN(pw2); FM_SBAR(); \
    FM_KR(15, kc_); FM_SBAR(); C1 = __builtin_amdgcn_mfma_f32_32x32x16_f16(kf[9], qr[4], C1, 0, 0, 0); sacc += P1[2]; sacc += P1[3]; FM_PIN(sacc); pw2[1] = FM_PKW(P1, 2); FM_PIN(pw2); FM_SBAR(); \
    FM_KR(16, kc_); FM_SBAR(); C0 = __builtin_amdgcn_mfma_f32_32x32x16_f16(kf[10], qr[5], C0, 0, 0, 0); sacc += P1[4]; sacc += P1[5]; FM_PIN(sacc); pw2[2] = FM_PKW(P1, 4); FM_PIN(pw2); FM_SBAR(); \
    FM_KR(17, kc_); FM_SBAR(); C1 = __builtin_amdgcn_mfma_f32_32x32x16_f16(kf[11], qr[5], C1, 0, 0, 0); sacc += P1[6]; sacc += P1[7]; FM_PIN(sacc); pw2[3] = FM_PKW(P1, 6); FM_PIN(pw2); FM_SBAR(); \
    FM_KR(18, kc_); FM_QL(8); FM_SBAR(); C0 = __builtin_amdgcn_mfma_f32_32x32x16_f16(kf[12], qr[6], C0, 0, 0, 0); sacc += P1[8]; sacc += P1[9]; FM_PIN(sacc); pw3[0] = FM_PKW(P1, 8); FM_PIN(pw3); FM_SBAR(); \
    FM_KR(19, kc_); FM_SBAR(); C1 = __builtin_amdgcn_mfma_f32_32x32x16_f16(kf[13], qr[6], C1, 0, 0, 0); sacc += P1[10]; sacc += P1[11]; FM_PIN(sacc); pw3[1] = FM_PKW(P1, 10); FM_PIN(pw3); FM_SBAR(); \
    FM_KR(20, kc_); FM_QL(9); FM_SBAR(); C0 = __builtin_amdgcn_mfma_f32_32x32x16_f16(kf[14], qr[7], C0, 0, 0, 0); sacc += P1[12]; sacc += P1[13]; FM_PIN(sacc); pw3[2] = FM_PKW(P1, 12); FM_PIN(pw3); FM_SBAR(); \
    FM_KR(21, kc_); FM_SBAR(); C1 = __builtin_amdgcn_mfma_f32_32x32x16_f16(kf[15], qr[7], C1, 0, 0, 0); sacc += P1[14]; sacc += P1[15]; FM_PIN(sacc); pw3[3] = FM_PKW(P1, 14); FM_PIN(pw3); FM_SBAR(); \
    FM_KR(22, kc_); FM_QL(10); FM_SBAR(); C0 = __builtin_amdgcn_mfma_f32_32x32x16_f16(kf[16], ql[0], C0, 0, 0, 0); FM_SBAR(); \
    FM_KR(23, kc_); FM_SBAR(); C1 = __builtin_amdgcn_mfma_f32_32x32x16_f16(kf[17], ql[0], C1, 0, 0, 0); FM_SBAR(); \
    FM_QL(11); FM_SBAR(); C0 = __builtin_amdgcn_mfma_f32_32x32x16_f16(kf[18], ql[1], C0, 0, 0, 0); FM_SBAR(); \
     C1 = __builtin_amdgcn_mfma_f32_32x32x16_f16(kf[19], ql[1], C1, 0, 0, 0); FM_SBAR(); \
    FM_VRD(0); FM_SBAR(); C0 = __builtin_amdgcn_mfma_f32_32x32x16_f16(kf[20], ql[2], C0, 0, 0, 0); FM_SBAR(); \
    FM_VRD(1); FM_SBAR(); C1 = __builtin_amdgcn_mfma_f32_32x32x16_f16(kf[21], ql[2], C1, 0, 0, 0); FM_SBAR(); \
    FM_VRD(2); FM_SBAR(); C0 = __builtin_amdgcn_mfma_f32_32x32x16_f16(kf[22], ql[3], C0, 0, 0, 0); FM_SBAR(); \
    FM_VRD(3); FM_SBAR(); C1 = __builtin_amdgcn_mfma_f32_32x32x16_f16(kf[23], ql[3], C1, 0, 0, 0); FM_SBAR(); \
    l_reg += sacc; \
    FM_CMASK(C0, C1, t); \
    { float a = FM_MX3(C0[0], C0[1], C1[0]), b = FM_MX3(C0[2], C0[3], C1[1]); a = FM_MX3(a, C1[2], C1[3]); \
      _Pragma("unroll") for (int r = 4; r < 16; r += 4) { a = FM_MX3(a, C0[r], C0[r + 1]); b = FM_MX3(b, C0[r + 2], C0[r + 3]); a = FM_MX3(a, C1[r], C1[r + 1]); b = FM_MX3(b, C1[r + 2], C1[r + 3]); } \
      float rm = __builtin_fmaxf(a, b); { auto rr = __builtin_amdgcn_permlane32_swap(__float_as_uint(rm), __float_as_uint(rm), false, false); rm = __builtin_fmaxf(__uint_as_float(rr[0]), __uint_as_float(rr[1])); } \
      resc = false; \
      if (__builtin_expect(__any(rm - mhat > (float)THRL), 0)) { const float dl = __builtin_fmaxf(rm - mhat, 0.f); mhat += dl; \
        const float f = __builtin_amdgcn_exp2f(-dl); l_reg *= f; if (hi == 0) wsf[r32] = f; resc = true; } } \
    FM_SBAR(); \
    FM_GAPB(FM_PVM(0, 0), C0, 0); FM_VRD(4); FM_SBAR(); \
    FM_GAPB(FM_PVM(1, 0), C0, 2); FM_VRD(5); FM_SBAR(); \
    FM_GAPB(FM_PVM(2, 0), C0, 4); FM_VRD(6); FM_SBAR(); \
    FM_GAPB(FM_PVM(3, 0), C0, 6); FM_VRD(7); FM_SBAR(); \
    FM_GAPB(FM_PVM(4, 1), C0, 8); FM_VRD(8); FM_SBAR(); \
    FM_GAPB(FM_PVM(5, 1), C0, 10); FM_VRD(9); FM_SBAR(); \
    FM_GAPB(FM_PVM(6, 1), C0, 12); FM_VRD(10); FM_SBAR(); \
    FM_GAPB(FM_PVM(7, 1), C0, 14); FM_VRD(11); FM_SBAR(); \
    FM_GAPB(FM_PVM(8, 2), C1, 0); FM_VRD(12); FM_SBAR(); \
    FM_GAPB(FM_PVM(9, 2), C1, 2); FM_VRD(13); FM_SBAR(); \
    FM_GAPB(FM_PVM(10, 2), C1, 4); FM_VRD(14); FM_SBAR(); \
    if (GL) { FM_KR(0, FM_KO(sl_next)); FM_KR(1, FM_KO(sl_next)); FM_SBAR(); } FM_GAPB(FM_PVM(11, 2), C1, 6); FM_VRD(15); FM_SBAR(); \
    if (GL) { FM_KR(2, FM_KO(sl_next)); FM_KR(3, FM_KO(sl_next)); FM_SBAR(); } FM_GAPB(FM_PVM(12, 3), C1, 8); \
    if (GL) { FM_KR(4, FM_KO(sl_next)); FM_KR(5, FM_KO(sl_next)); FM_SBAR(); } FM_GAPB(FM_PVM(13, 3), C1, 10); \
    FM_GAPB(FM_PVM(14, 3), C1, 12); \
    FM_GAPB(FM_PVM(15, 3), C1, 14); \
    } while (0)
    int t = 1;
#undef FM_CMASK
#define FM_CMASK(P0, P1, t) do { } while (0)
    for (; t + 5 < NT; t += 2) {
        FM_STEP(pB0, pB1, pA0, pA1, t, true, true, true);     FM_WAIT_BAR(0); FM_RESC(); FM_ROT();
        FM_STEP(pA0, pA1, pB0, pB1, t + 1, true, true, true); FM_WAIT_BAR(0); FM_RESC(); FM_ROT();
    }
#undef FM_CMASK
#define FM_CMASK(P0, P1, t) do { int jb_ = (t) - (NT - 4); if (jb_ >= 0) fa::cmask(P0, P1, 64 * jb_, qrel, hi); } while (0)
    for (; t + 1 < NT; t += 2) {
        FM_STEP(pB0, pB1, pA0, pA1, t, (t + 2 < NT), (t + 1 < NT), (t + 1 < NT));         FM_WAIT_BAR(0); FM_RESC(); FM_ROT();
        FM_STEP(pA0, pA1, pB0, pB1, t + 1, (t + 3 < NT), (t + 2 < NT), (t + 2 < NT));     FM_WAIT_BAR(0); FM_RESC(); FM_ROT();
    }
    FM_STEP(pB0, pB1, pA0, pA1, NT - 1, false, false, false); FM_RESC();
    { float sacc = pB0[0] + pB0[1];
#pragma unroll
      for (int r = 2; r < 16; ++r) sacc += pB0[r];
#pragma unroll
      for (int r = 0; r < 16; ++r) sacc += pB1[r];
      l_reg += sacc;
      pw0 = (u32x4){FM_PKW(pB0, 0), FM_PKW(pB0, 2), FM_PKW(pB0, 4), FM_PKW(pB0, 6)}; pw1 = (u32x4){FM_PKW(pB0, 8), FM_PKW(pB0, 10), FM_PKW(pB0, 12), FM_PKW(pB0, 14)};
      pw2 = (u32x4){FM_PKW(pB1, 0), FM_PKW(pB1, 2), FM_PKW(pB1, 4), FM_PKW(pB1, 6)}; pw3 = (u32x4){FM_PKW(pB1, 8), FM_PKW(pB1, 10), FM_PKW(pB1, 12), FM_PKW(pB1, 14)};
      FM_SBAR(); fd::pv(o, vb0 + sl_cur, FM_PAF(0), FM_PAF(1), FM_PAF(2), FM_PAF(3)); }
    { auto rr = __builtin_amdgcn_permlane32_swap(__float_as_uint(l_reg), __float_as_uint(l_reg), false, false); l_reg = __uint_as_float(rr[0]) + __uint_as_float(rr[1]); }
    if (hi == 0) wsf[32 + r32] = l_reg; asm volatile("s_waitcnt lgkmcnt(0)" ::: "memory");
    float rli[16];
#pragma unroll
    for (int r = 0; r < 16; ++r) rli[r] = __builtin_amdgcn_rcpf(wsf[32 + crow(r, hi)]);
    asm volatile("s_waitcnt lgkmcnt(0)\n\ts_barrier" ::: "memory");
    char* stg = shm + wid * (32 * 272);
#pragma unroll
    for (int r = 0; r < 16; ++r) { const int orow = crow(r, hi);
#pragma unroll
        for (int d0 = 0; d0 < 4; ++d0) *(h16*)(stg + orow * 272 + (d0 * 32 + r32) * 2) = (h16)(o[d0][r] * rli[r]); }
    asm volatile("s_waitcnt lgkmcnt(0)" ::: "memory");
    { h16* Ow = (h16*)(fd::ptab_abs(34) + WS_MIX) + (size_t)(t0 + q0 + wid * 32) * 1024 + 512 + h * 128; const int ch = lane & 15;
      const f32x8 g8v = *(const f32x8*)((const float*)fd::ptab_abs(13) + ch * 8);
#pragma unroll
      for (int i = 0; i < 8; ++i) { const int row = i * 4 + (lane >> 4);
          const h16x8 a = *(const h16x8*)(stg + row * 272 + ch * 16); float v[8];
#pragma unroll
          for (int e = 0; e < 8; ++e) v[e] = (float)a[e];
          float ss = 0.f;
#pragma unroll
          for (int e = 0; e < 8; ++e) ss += v[e] * v[e];
          ss += shx(ss, 1); ss += shx(ss, 2); ss += shx(ss, 4); ss += shx(ss, 8);
          const float rs = rsqrtf(ss * (1.f / 128.f) + RMS_EPS); h16x8 ov;
#pragma unroll
          for (int e = 0; e < 8; ++e) ov[e] = (h16)(v[e] * rs * g8v[e]);
          *(h16x8*)(Ow + (size_t)row * 1024 + ch * 8) = ov; } }
    asm volatile("s_waitcnt lgkmcnt(0)\n\ts_barrier" ::: "memory");
#undef FM_DMA_K
#undef FM_DMA_V
#undef FM_CMASK
#undef FM_RESC
#undef FM_ROT
#undef FM_KO
#undef FM_PKW
#undef FM_PAF
#undef FM_VFR
#undef FM_PIN
#undef FM_MX3
#undef FM_EX
#undef FM_GAPB
#undef FM_VRD
#undef FM_KR
#undef FM_QL
#undef FM_PVM
#undef FM_STEP
}
#undef FM_SBAR
#undef FM_WAIT_BAR
}
__device__ __forceinline__ void ph_attn_mla(char* lds, const h16* __restrict__ PROJp, const h16* __restrict__ QKVMp, h16* __restrict__ MIXp, int* __restrict__ qctr, const float* __restrict__ gm, const float* __restrict__ ropem) {
#pragma unroll 1
    for (int it = 0; ; ++it) {
        const int w = bid_fresh() + (it >> 1) * gdx(); if (w >= 256) break;
        const int qb = it ? (w >> 5) : 15 - (w >> 5), b = (w & 31) >> 2, h = w & 3; const int q0 = qb * 256; const size_t t0 = (size_t)b * SEQ;
        fm::attn_unit<8>((int)t0, h, q0, lds);
    }
}
__device__ __forceinline__ void ph_attn_diff(char* lds, const h16* __restrict__ PROJp, h16* __restrict__ MIXp, int* __restrict__ qctr, const float* __restrict__ roped, const float* __restrict__ gd,
                                             const float* __restrict__ lq1, const float* __restrict__ lk1, const float* __restrict__ lq2, const float* __restrict__ lk2) {
    const int lane = tid_fresh() & 63;
    const float lamv = __expf(wave_sum(lq1[lane] * lk1[lane])) - __expf(wave_sum(lq2[lane] * lk2[lane])) + 0.2f;
    const float lam = __builtin_bit_cast(float, __builtin_amdgcn_readfirstlane(__builtin_bit_cast(int, lamv)));
#pragma unroll 1
    for (int it = 0; ; ++it) {
        const int w = bid_fresh() + (it >> 1) * gdx(); if (w >= 256) break;
        const int qb = it ? (w >> 5) : 15 - (w >> 5), b = (w & 31) >> 2, h = w & 3; const int q0 = qb * 256; const size_t t0 = (size_t)b * SEQ;
        for (int mi = 0; mi < 2; ++mi) { const int m = 2 * h + mi;
            fd::attn_unit<8>((int)((t0 + q0) * NPROJ) + m * 64, (int)(t0 * NPROJ) + C_DK + m * 64, (int)(t0 * NPROJ) + C_DV + h * 128, (int)((t0 + q0) * 1024) + h * 128, (int)(t0 + q0), q0, lds, mi, lam); }
    }
}
__device__ __forceinline__ void ph_attn_cross(char* lds, const h16* __restrict__ QXp, const h16* __restrict__ MKVp, h16* __restrict__ OXp, const g8::DenseOrder& S) {
    g8::Unit u;
    for (int i = 0; S.next(i, u); ++i) {
        const int b = u.pm >> 4; const size_t t0 = (size_t)u.pm * 256;
        for (int hh = 0; hh < 2; ++hh) { const int h = 2 * u.pn + hh;
            fa::attn_unit<2>(QXp + t0 * 512 + h * 128, 512, MKVp + (size_t)b * NMEM * 1024 + h * 128, 1024, nullptr, 0, MKVp + (size_t)b * NMEM * 1024 + 512 + h * 128, 1024,
                             OXp + t0 * 512 + h * 128, 512, NMEM, 1 << 28, lds, 0, nullptr, 0.f, nullptr); }
    }
}

__global__ void __launch_bounds__(NTHR, 2) mega(Params p) {
    extern __shared__ __attribute__((aligned(16))) char smem[];
    if (threadIdx.x < 35) ((unsigned long long*)(smem + LDS_PTAB))[threadIdx.x] = ((const unsigned long long*)__builtin_amdgcn_kernarg_segment_ptr())[threadIdx.x];
    if (threadIdx.x == 0) *(uint4*)(smem + LDS_XB) = make_uint4(0u, 0u, 0u, 0u);
    if (threadIdx.x == 0) *(int*)(smem + LDS_GDX) = (int)gridDim.x;
    if ((threadIdx.x & 63) == 0) ((int*)(smem + LDS_WTAB))[hw_slot()] = (int)(threadIdx.x >> 6);
    static_assert(LDS_GDX == LDS_BYTES - 32, "LDS_GDX");
    __syncthreads();
#define PTAB(i) ({ const unsigned* _t = (const unsigned*)(smem + LDS_PTAB) + 2 * (i); const unsigned _lo = __builtin_amdgcn_readfirstlane(_t[0]), _hi = __builtin_amdgcn_readfirstlane(_t[1]); \
                   (char*)(__attribute__((address_space(1))) char*)(((unsigned long long)_hi << 32) | (unsigned long long)_lo); })
    (void)xcd_barrier_post((unsigned*)(PTAB(34) + WS_BAR), (volatile LAS unsigned*)(smem + LDS_XB));
#define GRID_BAR() do { XcdBarrier _b; _b.bar = (unsigned*)(PTAB(34) + WS_BAR); _b.x = xb_xcc_id(); _b.st = (volatile LAS unsigned*)(smem + LDS_XB); xcd_barrier(_b); } while (0)
#define WSF() PTAB(34)
#define FIN(i) ((const float*)PTAB(i))
#define XIN ((const float*)FIN(0))
#define POSIN ((const int*)PTAB(2))
#define ctl ((int*)(WSF() + WS_CTL))
#define WinT ((h16*)(WSF() + WS_WIN))
#define WupT ((h16*)(WSF() + WS_WUP))
#define WoT ((h16*)(WSF() + WS_WO))
#define WmqT ((h16*)(WSF() + WS_WMQ))
#define WmkvT ((h16*)(WSF() + WS_WMKV))
#define WmoT ((h16*)(WSF() + WS_WMO))
#define WguT ((h16*)(WSF() + WS_WGU))
#define WdT ((h16*)(WSF() + WS_WD))
#define Xh ((h16*)(WSF() + WS_XH))
#define MEMh ((h16*)(WSF() + WS_MEMH))
#define MKV ((h16*)(WSF() + WS_MKV))
#define PROJ ((h16*)(WSF() + WS_PROJ))
#define QKVM ((h16*)(WSF() + WS_QKVM))
#define MIX ((h16*)(WSF() + WS_MIX))
#define H2h ((h16*)(WSF() + WS_H2H))
#define H1h ((h16*)(WSF() + WS_H1H))
#define QX ((h16*)(WSF() + WS_QX))
#define STAT ((f32x2*)(WSF() + WS_PROJ))
#define MURS ((f32x2*)(WSF() + WS_PROJ + 4 * MiB))
#define CSBW ((float*)(WSF() + WS_RW + 512 * 1024))
#define OX ((h16*)(WSF() + WS_OX))
#define Hs ((h16*)(WSF() + WS_HS))
#define HsS ((h16*)(WSF() + WS_HSS))
#define Ssh ((h16*)(WSF() + WS_SSH))
#define Y ((h16*)(WSF() + WS_Y))
#define rope ((float*)(WSF() + WS_ROPE))
#define RWh ((h16*)(WSF() + WS_RW))
#define RWl ((h16*)(WSF() + WS_RW + 128 * 1024))
#define Y1 ((float*)(WSF() + WS_Y1))
#define H2 ((float*)PTAB(33))
#define topi ((int*)(WSF() + WS_TOP))
#define topw ((float*)(WSF() + WS_TOP + 1 * MiB))
#define rowtok ((int*)(WSF() + WS_LIST))
#define rowdst (rowtok + NCHUNK * ROWS_CH)
#define roww ((float*)(rowdst + NCHUNK * ROWS_CH))
    float* tile = (float*)smem;
    LAS unsigned char* ldsg = (LAS unsigned char*)smem;
    LAS int* t2e = (LAS int*)(smem + 131072);
    ph_cvt(XIN, Xh, (long)T * DM / 8);
    ph_cvt(FIN(1), MEMh, (long)TM * DM / 8);
    ph_tcvt<4>(tile, FIN(3), 1024, 1984, 1, WinT, 1024, 0, 0, 0L);
    ph_tcvt<0>(tile, FIN(10), 256, 768, 1, WupT, 256, 0, 0, 0L);
    ph_tcvt<0>(tile, FIN(12), 128, 1024, 1, WupT + (size_t)768 * 256, 256, 0, 0, 0L);
    ph_tcvt<0>(tile, FIN(14), 1024, 1024, 1, WoT, 1024, 0, 0, 0L);
    ph_tcvt<0, 4, 0, 0, true>(tile, FIN(17), 1024, 512, 1, WmqT, 1024, 0, 0, 0L, 0, -1, -2, 0, FIN(15));
    ph_tcvt<0>(tile, FIN(18), 1024, 512, 1, WmkvT, 1024, 0, 0, 0L);
    ph_tcvt<0>(tile, FIN(19), 1024, 512, 1, WmkvT, 1024, 0, 512, 0L);
    ph_tcvt<0>(tile, FIN(20), 512, 1024, 1, WmoT, 512, 0, 0, 0L);
    ph_rope_tables(POSIN, rope);
    {
        const float* rwf = FIN(23); h16* rh = RWh; h16* rl = RWl;
        for (int i = bid_fresh() * NTHR + tid_fresh(); i < DM * NE; i += gdx() * NTHR) { const int k = i >> 6, e = i & 63; const float w = rwf[i] * 1024.f; const h16 hi = (h16)w; rh[(size_t)e * DM + k] = hi; rl[(size_t)e * DM + k] = (h16)(w - (float)hi); }
    }
    {
        const int tid = tid_fresh(); typedef unsigned u32x4_ __attribute__((ext_vector_type(4))); const u32x4_ z = {0u, 0u, 0u, 0u};
        for (int i = bid_fresh() * NTHR + tid; i < 64 * 1024 / 8; i += gdx() * NTHR) *(u32x4_*)(WinT + (size_t)1984 * 1024 + (size_t)i * 8) = z;
        for (int i = bid_fresh() * NTHR + tid; i < 1024 * 16; i += gdx() * NTHR) *(u32x4_*)(WupT + (size_t)768 * 256 + (size_t)(i >> 4) * 256 + 128 + (i & 15) * 8) = z;
    }
    ph_list_init(rowtok, rowdst, roww);
    GRID_BAR();
    { g8::DenseOrder S; S.init(Xh, 1024, WinT, 1024, T, NPROJ); g8::gemm_phase<g8::EpiH, g8::DenseOrder, false, true>(ldsg, 1024, 1024, 1024, S, g8::EpiH{PROJ, NPROJ}); }
    GRID_BAR();
    { const int g_ = gdx(), b_ = bid_fresh(); const bool sp_ = g_ >= 64;
      if (!sp_ || b_ < 32) { g8::DenseOrder S; S.init(MEMh, 1024, WmkvT, 1024, TM, 1024); g8::gemm_phase<g8::EpiH, g8::DenseOrder, false, true>(ldsg, 1024, 1024, 1024, S, g8::EpiH{MKV, 1024}); }
      ph_postproj(PROJ, rope, FIN(9), FIN(11), sp_ ? b_ - 32 : b_, sp_ ? g_ - 32 : g_); }
    ph_lnfold(WmqT, FIN(17), FIN(16), CSBW);
    GRID_BAR();
    { g8::DenseOrder S; S.init(PROJ + C_CQ, NPROJ, WupT, 256, T, 768); g8::gemm_phase<g8::EpiH, g8::DenseOrder, false, true>(ldsg, 256, NPROJ, 256, S, g8::EpiH{QKVM, NUP}); }
    { g8::DenseOrder S; S.init(PROJ + C_CKV, NPROJ, WupT + (size_t)768 * 256, 256, T, 1024); g8::gemm_phase<g8::EpiH, g8::DenseOrder, false, true>(ldsg, 256, NPROJ, 256, S, g8::EpiH{QKVM + 768, NUP}); }
    if (gdx() == 256) { const int b_ = bid_fresh();
        ph_tcvt<1, 8, 1024, 256>(tile, FIN(25), 1024, 256, 64, WguT, 1024, 0, 0, (long)512 * 1024, b_ >= 128 ? 0 : 3136, b_ >= 128 ? 3136 : 4096, b_ >= 128 ? b_ - 128 : b_, 128); }
    GRID_BAR();
    const int gate0_ = gdx() == 256 ? 4096 : 0;
#define EXPERT_CVT() do { \
        ph_tcvt<1, 8, 1024, 256>(tile, FIN(25), 1024, 256, 64, WguT, 1024, 0, 0, (long)512 * 1024, gate0_, 4096, (int)bid_fresh(), (int)gdx()); \
        ph_tcvt<2, 8, 1024, 256>(tile, FIN(26), 1024, 256, 64, WguT, 1024, 0, 0, (long)512 * 1024); \
        ph_tcvt<3, 8, 256, 1024>(tile, FIN(27), 256, 1024, 64, WdT, 256, 0, 0, (long)1024 * 256); \
        ph_tcvt<1, 8, 1024, 256>(tile, FIN(28), 1024, 256, 1, WguT + (size_t)64 * 512 * 1024, 1024, 0, 0, 0L); \
        ph_tcvt<2, 8, 1024, 256>(tile, FIN(29), 1024, 256, 1, WguT + (size_t)64 * 512 * 1024, 1024, 0, 0, 0L); \
        ph_tcvt<0, 8, 256, 1024>(tile, FIN(30), 256, 1024, 1, WdT + (size_t)64 * 1024 * 256, 256, 0, 0, 0L); \
    } while (0)
    if ((bid_fresh() & 1) == 0) EXPERT_CVT();
    ph_attn_mla(smem, PROJ, QKVM, MIX, ctl + CW_AQ, FIN(13), rope + (size_t)T * 16);
    ph_attn_diff(smem, PROJ, MIX, ctl + CW_AQ + 64, rope, FIN(8), FIN(4), FIN(5), FIN(6), FIN(7));
    if ((bid_fresh() & 1) != 0) EXPERT_CVT();
    GRID_BAR();
    { g8::DenseOrder S; S.init(MIX, 1024, WoT, 1024, T, DM); g8::gemm_phase<g8::EpiResStat, g8::DenseOrder, false, true>(ldsg, 1024, 1024, 1024, S, g8::EpiResStat{Xh, H1h, STAT}); }
    GRID_BAR();
    { g8::DenseOrder S; S.init(H1h, 1024, WmqT, 1024, T, 512); ph_murs(S, STAT, MURS); g8::gemm_phase<g8::EpiLnQ, g8::DenseOrder, false, true>(ldsg, 1024, 1024, 1024, S, g8::EpiLnQ{QX, 512, MURS, CSBW});
      asm volatile("s_waitcnt vmcnt(0)" ::: "memory"); __syncthreads();
      ph_attn_cross(smem, QX, MKV, OX, S); }
    GRID_BAR();
    { g8::DenseOrder S; S.init(OX, 512, WmoT, 512, T, DM); g8::gemm_phase<g8::EpiResLn, g8::DenseOrder, false, true>(ldsg, 512, 512, 512, S, g8::EpiResLn{H1h, H2h, MURS, FIN(15), FIN(16)}); }
    GRID_BAR();
    ph_router(smem, H2h, FIN(21), FIN(22), RWh, RWl, FIN(24), topi, topw, ctl);
    GRID_BAR();
    { int* loff = (int*)smem; ph_offsets(loff, ctl); ph_fill(loff, topi, topw, ctl, rowtok, rowdst, roww); __syncthreads(); }
    { g8::DenseOrder S; S.init(H2h, 1024, WguT + (size_t)64 * 512 * 1024, 1024, T, 512); g8::gemm_phase<g8::EpiGU, g8::DenseOrder, false, true>(ldsg, 1024, 1024, 1024, S, g8::EpiGU{HsS, nullptr}); }
    GRID_BAR();
    { g8::DenseLight S; S.init(HsS, EDIM, WdT + (size_t)64 * 1024 * 256, EDIM, T, DM); S.init_light((2 * ((ctl + CW_OFF)[NE] >> 8)) % (int)gdx(), 4);
      g8::gemm_phase<g8::EpiRes<1>, g8::DenseLight, false, true>(ldsg, EDIM, EDIM, EDIM, S, g8::EpiRes<1>{nullptr, H2h, Ssh, nullptr}); }
#define MOE_GU(c) do { \
        const int ntile = ph_tile_map(t2e, ctl + CW_OFF + c * 66); \
        g8::GroupOrder S{(const char*)H2h, (const char*)WguT, rowtok + (size_t)c * ROWS_CH, t2e, (long)512 * 1024, 1024, 1024, ntile, 2, (int)gdx(), (int)bid_fresh(), true}; \
        g8::gemm_phase<g8::EpiGU, g8::GroupOrder, true, true>(ldsg, 1024, 1024, 1024, S, g8::EpiGU{Hs, roww + (size_t)c * ROWS_CH}); \
    } while (0)
#define MOE_DN(c) do { \
        const int ntile = (ctl + CW_OFF + c * 66)[NE] >> 8; \
        g8::GroupOrder S{(const char*)Hs, (const char*)WdT, rowtok + (size_t)c * ROWS_CH, t2e, (long)1024 * 256, EDIM, EDIM, ntile, 4, (int)gdx(), (int)bid_fresh(), false}; \
        g8::gemm_phase<g8::EpiDn, g8::GroupOrder, false, true>(ldsg, EDIM, EDIM, EDIM, S, g8::EpiDn{(unsigned char*)Y, rowdst + (size_t)c * ROWS_CH}); \
    } while (0)
#define MOE_CB(c, r) do { int tb_, tn_; cb_range(r, tb_, tn_); ph_combine((const unsigned char*)Y, Ssh, H2, c * TCH, FIN(31), FIN(32), tb_, tn_); } while (0)
    MOE_GU(0); GRID_BAR(); MOE_DN(0); GRID_BAR();
    MOE_GU(1); MOE_CB(0, (2 * ((ctl + CW_OFF + 66)[NE] >> 8)) % (int)gdx()); GRID_BAR(); MOE_DN(1); GRID_BAR();
    MOE_CB(1, 0);
    static_assert(NCHUNK == 2, "MoE phase program");
}

extern "C" void kernel_launch(void* const* d_in, const int* in_sizes, int n_in, void* d_out, int out_size, void* d_ws, size_t ws_size, hipStream_t stream) {
    if (n_in != 33 || ws_size < WS_END || out_size != T * DM) { fprintf(stderr, "kernel_launch: bad args n_in %d ws %zu out %d\n", n_in, ws_size, out_size); return; }
    static int grid = 0;
    if (!grid) {
        int dev = 0, cus = 0, per_cu = 0;
        (void)hipGetDevice(&dev); (void)hipDeviceGetAttribute(&cus, hipDeviceAttributeMultiprocessorCount, dev);
        if (hipFuncSetAttribute((const void*)mega, hipFuncAttributeMaxDynamicSharedMemorySize, LDS_BYTES) != hipSuccess) { fprintf(stderr, "kernel_launch: hipFuncSetAttribute failed\n"); return; }
        (void)hipOccupancyMaxActiveBlocksPerMultiprocessor(&per_cu, (const void*)mega, NTHR, LDS_BYTES);
        if (per_cu < 1 || cus < 1) { fprintf(stderr, "kernel_launch: occupancy %d cus %d\n", per_cu, cus); return; }
        grid = cus;
    }
    char* ws = (char*)d_ws;
    (void)hipMemsetAsync(ws + WS_CTL, 0, 128 * 1024, stream);
    Params p{};
    for (int i = 0; i < 33; ++i) p.in[i] = (const float*)d_in[i];
    p.out = (float*)d_out; p.ws = ws;
    hipLaunchKernelGGL(mega, dim3(grid), dim3(NTHR), LDS_BYTES, stream, p);
}
```

```cpp
#include <hip/hip_runtime.h>
#include <stdint.h>
#include <stdio.h>

typedef _Float16 h16;
typedef _Float16 h16x2 __attribute__((ext_vector_type(2)));
typedef _Float16 h16x4 __attribute__((ext_vector_type(4)));
typedef _Float16 h16x8 __attribute__((ext_vector_type(8)));
typedef float f32x2 __attribute__((ext_vector_type(2)));
typedef float f32x4 __attribute__((ext_vector_type(4)));
typedef float f32x8 __attribute__((ext_vector_type(8)));
typedef float f32x16 __attribute__((ext_vector_type(16)));

constexpr int NB = 8, SEQ = 4096, T = NB * SEQ, DM = 1024, NMEM = 256, TM = NB * NMEM;
constexpr int NPROJ = 2048;
constexpr int C_DQ = 0, C_DK = 512, C_DV = 1024, C_CQ = 1536, C_CKV = 1792, C_KR = 1920;
constexpr int NUP = 1792, KUP = 384;
constexpr int NE = 64, NE1 = 65, TOPK = 8, EDIM = 256, NSLOT = 8;
constexpr int NCHUNK = 2, TCH = T / NCHUNK;
constexpr int ROWS_CH = TCH * NSLOT + NE * 256;
constexpr float ALPHA = 1.189207115002721f;
constexpr float LN_EPS = 1e-5f, RMS_EPS = 1e-6f;
constexpr float LOG2E = 1.4426950408889634f;

constexpr size_t MiB = 1u << 20;
constexpr size_t WS_CTL = 0, WS_WIN = 1 * MiB, WS_WUP = 5 * MiB, WS_WO = 7 * MiB, WS_WMQ = 9 * MiB, WS_WMKV = 10 * MiB, WS_WMO = 12 * MiB,
                 WS_WGU = 13 * MiB, WS_WD = 78 * MiB, WS_LIST = 111 * MiB, WS_XH = 117 * MiB, WS_ROPE = 181 * MiB, WS_MEMH = 191 * MiB, WS_MKV = 195 * MiB,
                 WS_PROJ = 201 * MiB, WS_QKVM = 329 * MiB, WS_MIX = 441 * MiB;
constexpr size_t WS_TOP = 1 * MiB, WS_H2H = WS_XH, WS_Y1 = WS_PROJ, WS_H1H = WS_QKVM, WS_QX = 393 * MiB, WS_OX = 425 * MiB,
                 WS_HS = 181 * MiB, WS_Y = 253 * MiB, WS_SSH = 384 * MiB, WS_HSS = 493 * MiB, WS_END = 509 * MiB + 4096;
static_assert((size_t)ROWS_CH * EDIM * 2 <= WS_Y - WS_HS && (size_t)TCH * NSLOT * DM * 2 == 256 * MiB && (size_t)T * EDIM * 2 == 16 * MiB, "MoE buffers");
constexpr int CW_CNT = 0, CW_FILL = 512, CW_OFF = 1024, CW_AQ = 2048, CW_CQ = 3072;
constexpr size_t WS_BAR = 64 * 1024, WS_RW = 199 * MiB;

__device__ __forceinline__ int crow(int r, int hi) { return (r & 3) + 8 * (r >> 2) + 4 * hi; }
__device__ __forceinline__ int shxi(int i, int o) {
    switch (o) {
        case 1: return __builtin_amdgcn_ds_swizzle(i, 0x041f);
        case 2: return __builtin_amdgcn_ds_swizzle(i, 0x081f);
        case 4: return __builtin_amdgcn_ds_swizzle(i, 0x101f);
        case 8: return __builtin_amdgcn_ds_swizzle(i, 0x201f);
        default: return __builtin_amdgcn_ds_swizzle(i, 0x401f);
    }
}
__device__ __forceinline__ float shx(float v, int o) { return __int_as_float(shxi(__float_as_int(v), o)); }
__device__ __forceinline__ float half_sum(float v) { auto rr = __builtin_amdgcn_permlane32_swap(__float_as_uint(v), __float_as_uint(v), false, false); return __uint_as_float(rr[0]) + __uint_as_float(rr[1]); }
__device__ __forceinline__ float wave_sum(float v) {
    v = half_sum(v);
#pragma unroll
    for (int o = 16; o > 0; o >>= 1) v += shx(v, o);
    return v;
}


#define XB_TMO      128
#define XB_XCNT(j)  (256  + 64 * (j))
#define XB_XSUB(j)  (1280 + 64 * (j))
#define XB_XGEN(j)  (2304 + 64 * (j))
#define XB_TOP      3328
#define XB_TOPGEN   3392
#define XCD_BAR_WORDS 3456
#define XB_SPIN_CAP (1u << 18)
#define LAS __attribute__((address_space(3)))
constexpr int LDS_GDX = 163840 - 32;
constexpr int LDS_WTAB = 163840 - 512;
__device__ __forceinline__ int hw_slot() { return (int)(__builtin_amdgcn_s_getreg((6 - 1) << 11 | (0 << 6) | 4)); }
__device__ __forceinline__ int tid_fresh() { const int w = __builtin_amdgcn_readfirstlane(((const volatile LAS int*)LDS_WTAB)[hw_slot()]);
    unsigned z = 0u; asm volatile("" : "+v"(z));
    return w * 64 + (int)__builtin_amdgcn_mbcnt_hi(~0u, __builtin_amdgcn_mbcnt_lo(~0u, z)); }
__device__ __forceinline__ int gdx() { return __builtin_amdgcn_readfirstlane(*(volatile LAS const int*)LDS_GDX); }

__device__ __forceinline__ unsigned xb_ld(unsigned* p)              { return __hip_atomic_load(p, __ATOMIC_RELAXED, __HIP_MEMORY_SCOPE_AGENT); }
__device__ __forceinline__ unsigned xb_add(unsigned* p, unsigned v) { return __hip_atomic_fetch_add(p, v, __ATOMIC_RELAXED, __HIP_MEMORY_SCOPE_AGENT); }
__device__ __forceinline__ unsigned xb_xcc_id() { return (unsigned)__builtin_amdgcn_s_getreg((3 << 11) | 20) & 0xFu; }
#define XB_SPIN(cond, bar) do { unsigned _sp = 0; while (cond) { __builtin_amdgcn_s_sleep(1); \
    if ((++_sp & 255u) == 0u) { if (xb_ld(&(bar)[XB_TMO])) break; if (_sp > XB_SPIN_CAP) { atomicAdd(&(bar)[XB_TMO], 1u); break; } } } } while (0)

struct XcdBarrier {
    unsigned* bar; unsigned x;
    volatile LAS unsigned* st;
};
__device__ __forceinline__ XcdBarrier xcd_barrier_post(unsigned* bar, volatile LAS unsigned* st) {
    XcdBarrier b; b.bar = bar; b.x = xb_xcc_id(); b.st = st;
    if (tid_fresh() == 0) (void)xb_add(&bar[XB_XCNT(b.x)], 1u);
    return b;
}
__device__ __forceinline__ void xcd_barrier_complete(unsigned* bar, unsigned x, unsigned& nloc, unsigned& nx) {
    const unsigned G = (unsigned)gdx();
    unsigned sum, cnt, mine, sp = 0u;
    for (;;) {
        sum = 0u; cnt = 0u; mine = 0u;
#pragma unroll
        for (unsigned j = 0; j < 16; ++j) { const unsigned c = xb_ld(&bar[XB_XCNT(j)]); sum += c; cnt += (c > 0u) ? 1u : 0u; mine = (j == x) ? c : mine; }
        if (sum == G) break;
        __builtin_amdgcn_s_sleep(1);
        if ((++sp & 255u) == 0u) { if (xb_ld(&bar[XB_TMO])) break; if (sp > XB_SPIN_CAP) { atomicAdd(&bar[XB_TMO], 1u); break; } }
    }
    nloc = mine > 0u ? mine : 1u; nx = cnt > 0u ? cnt : 1u;
}
__device__ __forceinline__ void xcd_barrier(const XcdBarrier& b) {
    asm volatile("s_waitcnt vmcnt(0)" ::: "memory");
    __syncthreads();
    if (tid_fresh() == 0) {
        unsigned* bar = b.bar;
        __builtin_amdgcn_s_waitcnt(0);
        unsigned nloc = b.st[0], nx = b.st[1];
        if (nloc == 0u) { xcd_barrier_complete(bar, b.x, nloc, nx); b.st[0] = nloc; b.st[1] = nx; }
        const unsigned old = xb_add(&bar[XB_XSUB(b.x)], 1u);
        const unsigned gen = old / nloc;
        if (old + 1u == (gen + 1u) * nloc) {
            __builtin_amdgcn_fence(__ATOMIC_RELEASE, "agent");
            asm volatile("s_waitcnt vmcnt(0)" ::: "memory");
            const unsigned og = xb_add(&bar[XB_TOP], 1u);
            const unsigned tg = og / nx;
            if (og + 1u == (tg + 1u) * nx) xb_add(&bar[XB_TOPGEN], 1u);
            else XB_SPIN(xb_ld(&bar[XB_TOPGEN]) == tg, bar);
            __builtin_amdgcn_fence(__ATOMIC_ACQUIRE, "agent");
            xb_add(&bar[XB_XGEN(b.x)], 1u);
            asm volatile("s_waitcnt vmcnt(0)" ::: "memory");
        } else {
            XB_SPIN(xb_ld(&bar[XB_XGEN(b.x)]) == gen, bar);
            __builtin_amdgcn_fence(__ATOMIC_ACQUIRE, "agent");
            asm volatile("s_waitcnt vmcnt(0)" ::: "memory");
        }
    }
    __syncthreads();
}

struct Params { const float* in[33]; float* out; char* ws; };
constexpr int NTHR = 512, NWAVE = 8;
constexpr int LDS_BYTES = 163840;
constexpr int LDS_XB = LDS_BYTES - 16, LDS_PTAB = LDS_BYTES - 1024;

__device__ __forceinline__ int bid_fresh() { int t = blockIdx.x; asm volatile("" : "+s"(t)); return t; }

__device__ __forceinline__ void ph_cvt(const float* __restrict__ in, h16* __restrict__ out, long n8) {
    const long stride = gdx() * (long)NTHR;
    for (long i = bid_fresh() * (long)NTHR + tid_fresh(); i < n8; i += 4 * stride) {
        f32x4 xa[4], xb[4];
#pragma unroll
        for (int u = 0; u < 4; ++u) if (i + u * stride < n8) { const long iu = i + u * stride; const float* p = in + (iu & ~63L) * 8 + (iu & 63) * 4;
            xa[u] = __builtin_nontemporal_load((const f32x4*)p); xb[u] = __builtin_nontemporal_load((const f32x4*)(p + 256)); }
#pragma unroll
        for (int u = 0; u < 4; ++u) if (i + u * stride < n8) { const long iu = i + u * stride; h16* q = out + (iu & ~63L) * 8 + (iu & 63) * 4;
            *(h16x4*)q = (h16x4){(h16)xa[u][0], (h16)xa[u][1], (h16)xa[u][2], (h16)xa[u][3]}; *(h16x4*)(q + 256) = (h16x4){(h16)xb[u][0], (h16)xb[u][1], (h16)xb[u][2], (h16)xb[u][3]}; }
    }
}
template <int MODE, int PF = 4, int KC = 0, int NC = 0, bool KG = false>
__device__ __forceinline__ void ph_tcvt(float* tile  , const float* __restrict__ in, int K_, int N_, int nz, h16* __restrict__ out, int ldo, int koff, int roff, long zstride,
                                        int tbeg = 0, int tend = -1, int rank = -2, int nrank = 0, const float* __restrict__ kgain = nullptr) {
    const int K = KC ? KC : K_, N = NC ? NC : N_;
    const int tid = tid_fresh(); const int lk = tid >> 4, ln4 = (tid & 15) * 4, sn = tid >> 3, sk8 = (tid & 7) * 8;
    const int nk = K / 64, nn_ = N / 64; const int ntile = tend < 0 ? nk * nn_ * nz : tend; const int G = rank == -2 ? gdx() : nrank; const int first = rank == -2 ? bid_fresh() : (rank < 0 ? ntile : tbeg + rank); int buf = 0;
    f32x4 r0[PF], r1[PF];
#define TC_LOAD(slot, itx) do { const int it_ = (itx); if (it_ < ntile) { const int z_ = it_ / (nk * nn_), rem_ = it_ % (nk * nn_), k0_ = (rem_ % nk) * 64, n0_ = (rem_ / nk) * 64; \
        const float* p_ = in + (size_t)z_ * K * N + (size_t)(k0_ + lk) * N + n0_ + ln4; r0[slot] = __builtin_nontemporal_load((const f32x4*)p_); r1[slot] = __builtin_nontemporal_load((const f32x4*)(p_ + (size_t)32 * N)); } } while (0)
#pragma unroll
    for (int j = 0; j < PF; ++j) TC_LOAD(j, first + j * G);
    for (int it = first; it < ntile; it += PF * G) {
#pragma unroll
        for (int j = 0; j < PF; ++j) {
            const int itj = it + j * G;
            if (itj < ntile) {
                const int z = itj / (nk * nn_), rem = itj % (nk * nn_), k0 = (rem % nk) * 64, n0 = (rem / nk) * 64;
                h16* outz = out + (size_t)z * zstride; float* tb = tile + buf * (64 * 68);
                *(f32x4*)(tb + lk * 68 + (ln4 ^ (((lk >> 3) & 7) << 2))) = r0[j]; *(f32x4*)(tb + (lk + 32) * 68 + (ln4 ^ ((((lk >> 3) + 4) & 7) << 2))) = r1[j];
                TC_LOAD(j, itj + PF * G);
                __syncthreads();
                h16x8 o;
#pragma unroll
                for (int i = 0; i < 8; ++i) o[i] = (h16)(tb[(sk8 + i) * 68 + (sn ^ ((tid & 7) << 2))] * (KG ? kgain[k0 + sk8 + i] : 1.f));
                const int n = n0 + sn; int r;
                if (MODE == 0) r = n + roff;
                else if (MODE == 4) { const int d = n & 63; r = (n < 1024 && d < 16) ? (n & ~63) + 8 * ((d >> 2) & 1) + 4 * (d >> 3) + (d & 3) : n; }
                else if (MODE == 3) { const int ol = n & 255; r = (n >> 8) * 256 + ((ol >> 3) & 1) * 128 + (ol >> 6) * 32 + ((ol >> 2) & 1) * 16 + ((ol >> 4) & 3) * 4 + (ol & 3) + roff; } else { const int hh = n & 127; r = (n >> 7) * 256 + ((hh >> 2) & 1) * 128 + (hh >> 5) * 32 + (MODE == 2 ? 16 : 0) + ((hh >> 3) & 3) * 4 + (hh & 3) + roff; }
                *(h16x8*)(outz + (size_t)r * ldo + koff + k0 + sk8) = o;
                buf ^= 1;
            }
        }
    }
#undef TC_LOAD
    __syncthreads();
}
__device__ __forceinline__ void ph_rope_tables(const int* __restrict__ pos, float* __restrict__ rope, char* lds_) {
    float* lf = (float*)lds_;
    __syncthreads();
    if (tid_fresh() < 40) { const int j = tid_fresh(); const double ex = (j < 8) ? (double)(2 * j) / 16.0 : (double)(2 * (j - 8)) / 64.0;
        lf[j] = (float)exp2(-ex * 18.931568569324174); }
    __syncthreads();
    for (int i = bid_fresh() * NTHR + tid_fresh(); i < T * 40; i += gdx() * NTHR) {
        const int t = i / 40, j = i % 40; const float p = (float)pos[t];
        const float invf = lf[j];
        float sn, cs; sincosf(p * invf, &sn, &cs);
        if (j < 8) { rope[(size_t)t * 8 + j] = cs; rope[(size_t)T * 8 + (size_t)t * 8 + j] = sn; }
        else { const int jj = j - 8; rope[(size_t)T * 16 + (size_t)t * 32 + jj] = cs; rope[(size_t)T * 16 + (size_t)T * 32 + (size_t)t * 32 + jj] = sn; }
    }
}
__device__ __forceinline__ void ph_list_init(int* __restrict__ rowtok, int* __restrict__ rowdst, float* __restrict__ roww) {
    for (int i = bid_fresh() * NTHR + tid_fresh(); i < NCHUNK * ROWS_CH; i += gdx() * NTHR) { rowtok[i] = -1; rowdst[i] = TCH * NSLOT; roww[i] = 0.f; }
}

__device__ __forceinline__ void ph_postproj(h16* __restrict__ P, const float* __restrict__ rope, const float* __restrict__ gq, const float* __restrict__ gkv, int rank, int nrank) {
    const int lane = tid_fresh() & 63, l16 = lane & 15;
    for (int t = rank < 0 ? T : (rank * NWAVE + (tid_fresh() >> 6)) * 4 + (lane >> 4); t < T; t += nrank * NWAVE * 4) {
        h16* row = P + (size_t)t * NPROJ;
        const float* cd = rope + (size_t)t * 8; const float* cm = rope + (size_t)T * 16 + (size_t)t * 32; const float* sm = cm + (size_t)T * 32;
        h16* kp = row + C_DK + (l16 & 7) * 64 + (l16 >> 3) * 8;
        h16x8 ka = *(const h16x8*)kp; const f32x4 kc4 = *(const f32x4*)(cd + 4 * (l16 >> 3)), ks4 = *(const f32x4*)(cd + (size_t)T * 8 + 4 * (l16 >> 3));
        h16x8 q0 = *(const h16x8*)(row + C_CQ + l16 * 16), q1 = *(const h16x8*)(row + C_CQ + l16 * 16 + 8);
        h16x8 kv = *(const h16x8*)(row + C_CKV + l16 * 8);
        h16x4 kr = *(const h16x4*)(row + C_KR + l16 * 4);
        const f32x4 cm4 = *(const f32x4*)(cm + (l16 & 7) * 4), sm4 = *(const f32x4*)(sm + (l16 & 7) * 4);
        const f32x8 gq0 = *(const f32x8*)(gq + l16 * 16), gq1 = *(const f32x8*)(gq + l16 * 16 + 8), gk = *(const f32x8*)(gkv + l16 * 8);
#pragma unroll
        for (int j = 0; j < 4; ++j) { const float x1 = (float)ka[j], x2 = (float)ka[4 + j]; ka[j] = (h16)(x1 * kc4[j] - x2 * ks4[j]); ka[4 + j] = (h16)(x2 * kc4[j] + x1 * ks4[j]); }
        *(h16x8*)kp = ka;
        float fq[16], ssq = 0.f, fk[8], ssk = 0.f;
#pragma unroll
        for (int i = 0; i < 8; ++i) { fq[i] = (float)q0[i]; fq[8 + i] = (float)q1[i]; fk[i] = (float)kv[i]; ssq += fq[i] * fq[i] + fq[8 + i] * fq[8 + i]; ssk += fk[i] * fk[i]; }
#pragma unroll
        for (int o = 1; o < 16; o <<= 1) { ssq += shx(ssq, o); ssk += shx(ssk, o); }
        const float rq = rsqrtf(ssq * (1.f / 256.f) + RMS_EPS), rk = rsqrtf(ssk * (1.f / 128.f) + RMS_EPS);
#pragma unroll
        for (int i = 0; i < 8; ++i) { q0[i] = (h16)(fq[i] * rq * gq0[i]); q1[i] = (h16)(fq[8 + i] * rq * gq1[i]); kv[i] = (h16)(fk[i] * rk * gk[i]); }
        *(h16x8*)(row + C_CQ + l16 * 16) = q0; *(h16x8*)(row + C_CQ + l16 * 16 + 8) = q1; *(h16x8*)(row + C_CKV + l16 * 8) = kv;
#pragma unroll
        for (int j = 0; j < 4; ++j) { const float mine = (float)kr[j]; const float other = shx(mine, 8);
            const float x1 = (l16 < 8) ? mine : other, x2 = (l16 < 8) ? other : mine;
            kr[j] = (h16)((l16 < 8) ? (x1 * cm4[j] - x2 * sm4[j]) : (x2 * cm4[j] + x1 * sm4[j])); }
        *(h16x4*)(row + C_KR + l16 * 4) = kr;
    }
}
template <int NR>
__device__ __forceinline__ void ln_rows(h16* H, const float* __restrict__ g, const float* __restrict__ bta, int t, int lane) {
    h16x8 x[NR][2]; f32x8 v[NR][2]; float s[NR];
#pragma unroll
    for (int r = 0; r < NR; ++r) {
#pragma unroll
        for (int i = 0; i < 2; ++i) x[r][i] = *(const h16x8*)(H + (size_t)(t + r) * DM + i * 512 + lane * 8); }
#pragma unroll
    for (int r = 0; r < NR; ++r) { s[r] = 0.f;
#pragma unroll
        for (int i = 0; i < 2; ++i)
#pragma unroll
            for (int e = 0; e < 8; ++e) { v[r][i][e] = (float)x[r][i][e]; s[r] += v[r][i][e]; } }
#pragma unroll
    for (int r = 0; r < NR; ++r) s[r] = half_sum(s[r]);
#pragma unroll
    for (int o = 16; o > 0; o >>= 1) {
#pragma unroll
        for (int r = 0; r < NR; ++r) s[r] += shx(s[r], o); }
    float q[NR];
#pragma unroll
    for (int r = 0; r < NR; ++r) { const float mu = s[r] * (1.f / DM); q[r] = 0.f;
#pragma unroll
        for (int i = 0; i < 2; ++i)
#pragma unroll
            for (int e = 0; e < 8; ++e) { v[r][i][e] -= mu; q[r] += v[r][i][e] * v[r][i][e]; } }
#pragma unroll
    for (int r = 0; r < NR; ++r) q[r] = half_sum(q[r]);
#pragma unroll
    for (int o = 16; o > 0; o >>= 1) {
#pragma unroll
        for (int r = 0; r < NR; ++r) q[r] += shx(q[r], o); }
#pragma unroll
    for (int i = 0; i < 2; ++i) { const int c = i * 512 + lane * 8; const f32x8 gg = *(const f32x8*)(g + c), bb = *(const f32x8*)(bta + c);
#pragma unroll
        for (int r = 0; r < NR; ++r) { const float rs = rsqrtf(q[r] * (1.f / DM) + LN_EPS); h16x8 o;
#pragma unroll
            for (int e = 0; e < 8; ++e) o[e] = (h16)(v[r][i][e] * rs * gg[e] + bb[e]);
            *(h16x8*)(H + (size_t)(t + r) * DM + c) = o; } }
}
__device__ __forceinline__ void ph_lnfold(const h16* __restrict__ WmqTp, const float* __restrict__ Wmq, const float* __restrict__ b1, float* __restrict__ csbw) {
    const int lane = tid_fresh() & 63;
    for (int n = bid_fresh() * NWAVE + (tid_fresh() >> 6); n < 512; n += gdx() * NWAVE) {
        const h16x8 w0 = *(const h16x8*)(WmqTp + (size_t)n * 1024 + lane * 16), w1 = *(const h16x8*)(WmqTp + (size_t)n * 1024 + lane * 16 + 8);
        float c = 0.f, b = 0.f;
#pragma unroll
        for (int i = 0; i < 8; ++i) c += (float)w0[i] + (float)w1[i];
#pragma unroll
        for (int i = 0; i < 16; ++i) { const int k = lane * 16 + i; b += b1[k] * Wmq[(size_t)k * 512 + n]; }
        c = wave_sum(c); b = wave_sum(b);
        if (lane == 0) { csbw[n] = c; csbw[512 + n] = b; }
    }
}
__device__ __forceinline__ void ph_ln(h16* H, const float* __restrict__ g, const float* __restrict__ bta) {
    const int lane = tid_fresh() & 63;
    for (int t = (bid_fresh() * NWAVE + (tid_fresh() >> 6)) * 4; t < T; t += gdx() * NWAVE * 4) ln_rows<4>(H, g, bta, t, lane);
}
__device__ __forceinline__ void ph_router(char* lds, h16* H2hp, const float* __restrict__ lng, const float* __restrict__ lnb, const h16* __restrict__ rwh, const h16* __restrict__ rwl, const float* __restrict__ rb, int* __restrict__ topi, float* __restrict__ topw, int* __restrict__ ctlp) {
    constexpr int BST = 68, BSH = 72;
    const int tid = tid_fresh(), wv = tid >> 6, lane = tid & 63, j16 = lane & 15, kq = lane >> 4;
    h16* Bl = (h16*)lds;
    float* Lg = (float*)(lds + 2 * 2 * 64 * BSH * 2) + wv * (16 * BST);
    int* lcnt = (int*)(lds + 2 * 2 * 64 * BSH * 2 + NWAVE * 16 * BST * 4);
    for (int t0 = bid_fresh() * 128; t0 < T; t0 += gdx() * 128) {
        for (int rr = 0; rr < 16; rr += 4) ln_rows<4>(H2hp, lng, lnb, t0 + wv * 16 + rr, lane);
        asm volatile("s_waitcnt vmcnt(0)" ::: "memory");
        __syncthreads();
        if (tid < 64) lcnt[tid] = 0;
        const h16* xrow = H2hp + (size_t)(t0 + wv * 16 + j16) * DM + 8 * kq;
        f32x4 acc[4];
#pragma unroll
        for (int nb = 0; nb < 4; ++nb) acc[nb] = (f32x4){0.f, 0.f, 0.f, 0.f};
        const int se = (tid >> 2) & 63, sseg = (tid & 3) * 16; const h16* wsrc = (tid < 256 ? rwh : rwl) + (size_t)se * DM + sseg;
        h16* Bw = Bl + (tid >> 8) * (64 * BSH) + se * BSH + sseg;
        h16x8 breg[2];
        breg[0] = *(const h16x8*)wsrc; breg[1] = *(const h16x8*)(wsrc + 8);
        *(h16x8*)Bw = breg[0]; *(h16x8*)(Bw + 8) = breg[1];
        h16x8 a0n = *(const h16x8*)xrow, a1n = *(const h16x8*)(xrow + 32);
        __syncthreads();
        for (int c = 0; c < 16; ++c) {
            const h16* Bc = Bl + (c & 1) * (2 * 64 * BSH);
            if (c + 1 < 16) { breg[0] = *(const h16x8*)(wsrc + (c + 1) * 64); breg[1] = *(const h16x8*)(wsrc + (c + 1) * 64 + 8); }
            const h16x8 a0 = a0n, a1 = a1n;
            if (c + 1 < 16) { a0n = *(const h16x8*)(xrow + (c + 1) * 64); a1n = *(const h16x8*)(xrow + (c + 1) * 64 + 32); }
#pragma unroll
            for (int nb = 0; nb < 4; ++nb) { const h16* bp = Bc + (16 * nb + j16) * BSH + 8 * kq;
                acc[nb] = __builtin_amdgcn_mfma_f32_16x16x32_f16(a0, *(const h16x8*)bp, acc[nb], 0, 0, 0);
                acc[nb] = __builtin_amdgcn_mfma_f32_16x16x32_f16(a0, *(const h16x8*)(bp + 64 * BSH), acc[nb], 0, 0, 0);
                acc[nb] = __builtin_amdgcn_mfma_f32_16x16x32_f16(a1, *(const h16x8*)(bp + 32), acc[nb], 0, 0, 0);
                acc[nb] = __builtin_amdgcn_mfma_f32_16x16x32_f16(a1, *(const h16x8*)(bp + 64 * BSH + 32), acc[nb], 0, 0, 0); }
            if (c + 1 < 16) { h16* Bn = Bw + ((c + 1) & 1) * (2 * 64 * BSH); *(h16x8*)Bn = breg[0]; *(h16x8*)(Bn + 8) = breg[1]; }
            __syncthreads();
        }
#pragma unroll
        for (int nb = 0; nb < 4; ++nb) acc[nb] *= (1.f / 1024.f);
#pragma unroll
        for (int nb = 0; nb < 4; ++nb)
#pragma unroll
            for (int r = 0; r < 4; ++r) Lg[(4 * kq + r) * BST + 16 * nb + j16] = acc[nb][r];
        asm volatile("s_waitcnt lgkmcnt(0)" ::: "memory");
        const int tt = lane >> 2, part = lane & 3; const int t = t0 + wv * 16 + tt;
        float sc[16], ch[16];
#pragma unroll
        for (int q = 0; q < 4; ++q) { const f32x4 lg = *(const f32x4*)(Lg + tt * BST + 16 * part + 4 * q); const f32x4 bb = *(const f32x4*)(rb + 16 * part + 4 * q);
#pragma unroll
            for (int e = 0; e < 4; ++e) { const float sg = 1.f / (1.f + expf(-lg[e])); sc[4 * q + e] = sg; ch[4 * q + e] = sg + bb[e]; } }
        float gsl[2];
#pragma unroll
        for (int g = 0; g < 2; ++g) { float m1 = -1e30f, m2 = -1e30f;
#pragma unroll
            for (int e = 0; e < 8; ++e) { const float v = ch[g * 8 + e]; if (v > m1) { m2 = m1; m1 = v; } else if (v > m2) m2 = v; }
            gsl[g] = m1 + m2; }
        float gs[8];
#pragma unroll
        for (int pp = 0; pp < 4; ++pp) { gs[2 * pp] = __shfl(gsl[0], (lane & ~3) | pp); gs[2 * pp + 1] = __shfl(gsl[1], (lane & ~3) | pp); }
        unsigned gmask = 0;
#pragma unroll
        for (int it = 0; it < 4; ++it) { float best = -3e38f; int bi = 0;
#pragma unroll
            for (int g = 0; g < 8; ++g) if (!((gmask >> g) & 1) && gs[g] > best) { best = gs[g]; bi = g; }
            gmask |= 1u << bi; }
#pragma unroll
        for (int e = 0; e < 16; ++e) if (!((gmask >> (2 * part + (e >> 3))) & 1)) ch[e] = -1e30f;
        float wsel[8]; int isel[8]; float wsum = 0.f;
#pragma unroll
        for (int it = 0; it < 8; ++it) {
            float bv = -3e38f; int be = 0; float bs = 0.f;
#pragma unroll
            for (int e = 0; e < 16; ++e) if (ch[e] > bv) { bv = ch[e]; be = e; bs = sc[e]; }
            int bidx = 16 * part + be;
#pragma unroll
            for (int o = 1; o < 4; o <<= 1) { const float ov = shx(bv, o); const int oi = shxi(bidx, o); const float os = shx(bs, o);
                if (ov > bv || (ov == bv && oi < bidx)) { bv = ov; bidx = oi; bs = os; } }
#pragma unroll
            for (int e = 0; e < 16; ++e) if (bidx == 16 * part + e) ch[e] = -3e38f;
            wsel[it] = bs; isel[it] = bidx; wsum += bs;
        }
        const float inv = 2.5f / wsum;
#pragma unroll
        for (int it = 0; it < 8; ++it) if ((it >> 1) == part) { topi[(size_t)t * 8 + it] = isel[it]; topw[(size_t)t * 8 + it] = wsel[it] * inv; atomicAdd(&lcnt[isel[it]], 1); }
        __syncthreads();
        if (tid < 64) { const int n = lcnt[tid]; if (n) atomicAdd(&ctlp[CW_CNT + (t0 / TCH) * 64 + tid], n); }
    }
}
__device__ __forceinline__ void ph_offsets(int* loff  , int* __restrict__ ctlp) {
    int* lcnt = loff + 320;
    __syncthreads();
    if (tid_fresh() < NCHUNK * 64) lcnt[tid_fresh()] = (__hip_atomic_load(&ctlp[CW_CNT + tid_fresh()], __ATOMIC_RELAXED, __HIP_MEMORY_SCOPE_AGENT) + 255) & ~255;
    __syncthreads();
    if (tid_fresh() < NCHUNK * 64) { const int c = tid_fresh() >> 6, e = tid_fresh() & 63; int o = 0;
        for (int i = 0; i < e; ++i) o += lcnt[c * 64 + i];
        loff[c * 66 + e] = o;
        if (e == 63) { const int tot = o + lcnt[c * 64 + 63]; loff[c * 66 + 64] = tot; loff[c * 66 + 65] = tot; } }
    __syncthreads();
    if (bid_fresh() == 0 && tid_fresh() < NCHUNK * 66) ctlp[CW_OFF + tid_fresh()] = loff[tid_fresh()];
}
__device__ __forceinline__ void ph_fill(int* loff, const int* __restrict__ topi, const float* __restrict__ topw, int* __restrict__ ctlp, int* __restrict__ rowtok, int* __restrict__ rowdst, float* __restrict__ roww) {
    int* lc = loff + NCHUNK * 66; int* lbase = lc + 64;
    const int tid = tid_fresh();
    for (int t0 = bid_fresh() * 128; t0 < T; t0 += gdx() * 128) {
        const int c = t0 / TCH;
        __syncthreads();
        if (tid < 64) lc[tid] = 0;
        __syncthreads();
        int e0 = 0, e1 = 0; float w0 = 0.f, w1 = 0.f;
        const int t = t0 + (tid >> 2), s0 = (tid & 3) * 2;
        { e0 = topi[(size_t)t * 8 + s0]; e1 = topi[(size_t)t * 8 + s0 + 1]; w0 = topw[(size_t)t * 8 + s0]; w1 = topw[(size_t)t * 8 + s0 + 1]; }
        atomicAdd(&lc[e0], 1); atomicAdd(&lc[e1], 1);
        __syncthreads();
        if (tid < 64) { const int n = lc[tid]; lbase[tid] = loff[c * 66 + tid] + (n ? atomicAdd(&ctlp[CW_FILL + c * 64 + tid], n) : 0); lc[tid] = 0; }
        __syncthreads();
        const int p0 = lbase[e0] + atomicAdd(&lc[e0], 1), p1 = lbase[e1] + atomicAdd(&lc[e1], 1);
        const int tl = t % TCH; const size_t o0 = (size_t)c * ROWS_CH + p0, o1 = (size_t)c * ROWS_CH + p1;
        rowtok[o0] = t; rowdst[o0] = tl * NSLOT + s0; roww[o0] = w0;
        rowtok[o1] = t; rowdst[o1] = tl * NSLOT + s0 + 1; roww[o1] = w1;
        }
}
__device__ __forceinline__ void cb_range(int r, int& tb, int& tn) {
    constexpr int DELTA = 64;
    const int G = gdx(), c = bid_fresh(), nl = r ? G - r : 0;
    int de = nl ? (TCH / nl < DELTA ? TCH / nl : DELTA) : 0;
    const int base = (TCH - nl * de) / G, rem = TCH - nl * de - base * G;
    const int cl0 = c > r ? c - r : 0, cl1 = c + 1 > r ? c + 1 - r : 0;
    const int s0 = c * base + (r ? cl0 * de : 0) + (c < rem ? c : rem), s1 = (c + 1) * base + (r ? cl1 * de : 0) + (c + 1 < rem ? c + 1 : rem);
    tb = s0; tn = s1 - s0;
}
__device__ __forceinline__ void ph_combine(const unsigned char* __restrict__ Y8, const h16* __restrict__ Sp, float* __restrict__ HO, int t0, const float* __restrict__ g, const float* __restrict__ bta, int tb, int tn) {
    const int lane = tid_fresh() & 63, wv_ = tid_fresh() >> 6;
    for (int tl = tb + wv_; tl < tb + tn; tl += NWAVE) {
        const int t = t0 + tl; float* h = HO + (size_t)t * DM + lane * 4;
        unsigned y[NSLOT][4];
#pragma unroll
        for (int sl = 0; sl < NSLOT; ++sl)
#pragma unroll
            for (int i = 0; i < 4; ++i) y[sl][i] = __builtin_nontemporal_load((const unsigned*)(Y8 + ((size_t)tl * NSLOT + sl) * DM + i * 256 + lane * 4));
        f32x4 v[4];
#pragma unroll
        for (int i = 0; i < 4; ++i) { const h16x4 s0 = __builtin_nontemporal_load((const h16x4*)(Sp + (size_t)t * DM + i * 256 + lane * 4)); v[i] = (f32x4){(float)s0[0], (float)s0[1], (float)s0[2], (float)s0[3]}; }
        f32x4 a[4];
#pragma unroll
        for (int i = 0; i < 4; ++i) a[i] = (f32x4){0.f, 0.f, 0.f, 0.f};
#pragma unroll
        for (int sl = 0; sl < NSLOT; ++sl)
#pragma unroll
            for (int i = 0; i < 4; ++i) { const f32x2 lo = __builtin_amdgcn_cvt_pk_f32_fp8((int)y[sl][i], false), hi = __builtin_amdgcn_cvt_pk_f32_fp8((int)y[sl][i], true);
                a[i][0] += lo[0]; a[i][1] += lo[1]; a[i][2] += hi[0]; a[i][3] += hi[1]; }
        float s = 0.f;
#pragma unroll
        for (int i = 0; i < 4; ++i) { v[i] += a[i] * (1.f / 16.f); s += (v[i][0] + v[i][1]) + (v[i][2] + v[i][3]); }
        const float mu = wave_sum(s) * (1.f / DM); float q = 0.f;
#pragma unroll
        for (int i = 0; i < 4; ++i) { v[i] -= mu; q += (v[i][0] * v[i][0] + v[i][1] * v[i][1]) + (v[i][2] * v[i][2] + v[i][3] * v[i][3]); }
        const float rs = rsqrtf(wave_sum(q) * (1.f / DM) + LN_EPS);
#pragma unroll
        for (int i = 0; i < 4; ++i) { const int c = i * 256 + lane * 4; *(f32x4*)(h + i * 256) = v[i] * rs * *(const f32x4*)(g + c) + *(const f32x4*)(bta + c); }
    }
}

namespace g8 {
constexpr int BM = 256, BK = 64, HALF = 128, HTB = HALF * BK * 2, STAGE_BYTES = 8 * HTB, NXCD = 8, WGM = 1;
__host__ __device__ __forceinline__ int lds_byte(int r, int c) { const int st = (r >> 4) * 2 + (c >> 5), rr = r & 15, cc = c & 31, ob = rr * 64 + cc * 2; return st * 1024 + (ob ^ (((ob >> 9) & 1) << 5)); }
__host__ __device__ __forceinline__ void stage_rc(int b, int& R, int& C) { const int st = b / 1024, sb = b % 1024, swz = sb ^ (((sb >> 9) & 1) << 5); R = (st >> 1) * 16 + swz / 64; C = (st & 1) * 32 + (swz % 64) / 2; }
__host__ __device__ __forceinline__ int perm32(int rho) { const int n = rho >> 4, i = rho & 15; return 8 * (i >> 2) + 4 * n + (i & 3); }
struct Unit { const char* a; const char* b; const int* rows; int pm, pn, e, pad; };
struct DenseOrder {
    const char* A; const char* Bt; int lda, ldb, nM, nN, nwg, G, c;
    __device__ __forceinline__ void init(const h16* A_, int lda_, const h16* Bt_, int ldb_, int M, int N) { A = (const char*)A_; Bt = (const char*)Bt_; lda = lda_; ldb = ldb_; nM = M / BM; nN = N / BM; nwg = nM * nN; G = gdx(); c = bid_fresh(); }
    __device__ __forceinline__ bool tile(long L, Unit& u) const {
        if (L >= nwg) return false;
        int wgid = (int)L; { const int q = nwg / NXCD, r = nwg % NXCD, xcd = wgid % NXCD, off = wgid / NXCD; wgid = (xcd < r ? xcd * (q + 1) : r * (q + 1) + (xcd - r) * q) + off; }
        const int nig = WGM * nN, gid = wgid / nig, fm = gid * WGM, gsz = (nM % WGM == 0) ? WGM : ((nM - fm) < WGM ? (nM - fm) : WGM);
        u.pm = fm + ((wgid % nig) % gsz); u.pn = (wgid % nig) / gsz; u.e = 0; u.rows = nullptr;
        u.a = A + (size_t)u.pm * BM * lda * 2; u.b = Bt + (size_t)u.pn * BM * ldb * 2; return true;
    }
    __device__ __forceinline__ bool next(int i, Unit& u) const { return tile((long)i * G + c, u); }
};
struct DenseLight : DenseOrder {
    int r, nl, cap;
    __device__ __forceinline__ void init_light(int r_, int Q) { r = r_ ? ((r_ + 7) & ~7) : 0; if (r > G) r = G; nl = G - r; cap = r ? (nwg < Q * nl ? nwg : Q * nl) : 0; }
    __device__ __forceinline__ bool next(int i, Unit& u) const {
        long L;
        if (r && c >= r) { const int cl = c - r; const int mine = cl < cap ? (cap - cl + nl - 1) / nl : 0; L = i < mine ? (long)i * nl + cl : (long)cap + (long)(i - mine) * G + c; }
        else L = (long)cap + (long)i * G + c;
        return tile(L, u);
    }
};
struct GroupOrder {
    const char* A; const char* Bt; const int* rows; const LAS int* t2e; long bstride; int lda, ldb, ntile, nN, G, c; bool gather;
    __device__ __forceinline__ bool next(int i, Unit& u) const {
        const long L = (long)i * G + c; const int total = ntile * nN; if (L >= total) return false;
        int wg = (int)L; { const int q = total / NXCD, r = total % NXCD, xcd = wg % NXCD, off = wg / NXCD; wg = (xcd < r ? xcd * (q + 1) : r * (q + 1) + (xcd - r) * q) + off; }
        const int rt = wg / nN; u.pm = rt; u.pn = wg % nN; u.e = t2e[rt];
        u.rows = rows + (size_t)rt * BM; u.a = gather ? A : A + (size_t)rt * BM * lda * 2; u.b = Bt + (size_t)u.e * bstride * 2 + (size_t)u.pn * BM * ldb * 2; return true;
    }
};

template <class Epi, class Sched, bool GATHER, bool ALIGN_EPI>
__device__ __forceinline__ void gemm_phase(LAS unsigned char* lds, int K, int lda, int ldb, const Sched& S, const Epi& E) {
    const int tid = tid_fresh(), wid = __builtin_amdgcn_readfirstlane(tid >> 6), lane = tid & 63, wr = wid >> 2, wc = wid & 3, fr = lane & 15, fq = lane >> 4;
    const int nt = K / BK;
    int Rs[2], C2[2]; unsigned voffB[2], voffA[2][2], voffAn[2][2];
#pragma unroll
    for (int i = 0; i < 2; ++i) { int R, C; stage_rc(tid * 16 + i * 8192, R, C); const int Rb = Epi::PERM ? ((R & ~31) + perm32(R & 31)) : R;
        Rs[i] = R; C2[i] = C * 2; voffB[i] = (unsigned)(Rb * ldb + C) * 2u;
#pragma unroll
        for (int h = 0; h < 2; ++h) { voffA[h][i] = (unsigned)((h * HALF + R) * lda + C) * 2u; voffAn[h][i] = voffA[h][i]; } }
    const size_t kstep = (size_t)(BK * 2);
    const size_t hstepB = (size_t)HALF * ldb * 2;
    const unsigned ldsw = (unsigned)wid * 1024u;
    const int aoff = lds_byte(wr * 64 + fr, fq * 8), boff = lds_byte(wc * 32 + fr, fq * 8);
#define G8_SA(b, h) (((b) * 2 + (h)) * HTB)
#define G8_SB(b, h) ((4 + (b) * 2 + (h)) * HTB)
#define G8_STAGE(bufoff, gbase, voff) do { _Pragma("unroll") for (int _i = 0; _i < 2; ++_i) \
        __builtin_amdgcn_global_load_lds((const unsigned*)((const char*)(gbase) + (voff)[_i]), (LAS unsigned*)(lds + (bufoff) + ldsw + _i * 8192), 16, 0, 0); } while (0)
#define G8_LDA(dst, b, h) do { _Pragma("unroll") for (int m = 0; m < 4; ++m) _Pragma("unroll") for (int k = 0; k < 2; ++k) dst[m][k] = *(const LAS h16x8*)(lds + G8_SA(b, h) + aoff + m * 2048 + k * 1024); } while (0)
#define G8_LDB(dst, b, h) do { _Pragma("unroll") for (int n = 0; n < 2; ++n) _Pragma("unroll") for (int k = 0; k < 2; ++k) dst[n][k] = *(const LAS h16x8*)(lds + G8_SB(b, h) + boff + n * 2048 + k * 1024); } while (0)
#define G8_MMA(ai, bj, At, Bt) do { __builtin_amdgcn_s_setprio(1); _Pragma("unroll") for (int m = 0; m < 4; ++m) _Pragma("unroll") for (int n = 0; n < 2; ++n) _Pragma("unroll") for (int k = 0; k < 2; ++k) \
        acc[ai][bj][m][n] = __builtin_amdgcn_mfma_f32_16x16x32_f16(Bt[n][k], At[m][k], acc[ai][bj][m][n], 0, 0, 0); __builtin_amdgcn_s_setprio(0); } while (0)
#define G8_WAIT_V(n) asm volatile("s_waitcnt vmcnt(" #n ")" ::: "memory")
#define G8_WAIT_L(n) asm volatile("s_waitcnt lgkmcnt(" #n ")" ::: "memory")
#define G8_BAR __builtin_amdgcn_s_barrier()
#define G8_SCHED __builtin_amdgcn_sched_barrier(0)
#define G8_ROWS(dst, u) do { if constexpr (GATHER) { _Pragma("unroll") for (int _h = 0; _h < 2; ++_h) _Pragma("unroll") for (int _i = 0; _i < 2; ++_i) { \
        int _r = (u).rows[_h * HALF + Rs[_i]]; _r = _r < 0 ? 0 : _r; dst[_h][_i] = (unsigned)_r * (unsigned)(lda * 2) + (unsigned)C2[_i]; } } } while (0)
    Unit cur, nxt; int ui = 0;
    if (!S.next(0, cur)) return;
    f32x4 acc[2][2][4][2];
    E.init(acc, cur, wr, wc, fr, fq);
    h16x8 At[4][2], B0[2][2], B1[2][2];
    G8_ROWS(voffA, cur);
    const char* cA = cur.a; const char* cB = cur.b;
    G8_STAGE(G8_SB(0, 0), cB, voffB); G8_STAGE(G8_SB(0, 1), cB + hstepB, voffB); G8_STAGE(G8_SA(0, 0), cA, voffA[0]); G8_STAGE(G8_SA(0, 1), cA, voffA[1]);
    if (wr == 1) G8_BAR;
    G8_WAIT_V(2); G8_BAR;
    G8_STAGE(G8_SB(1, 0), cB + kstep, voffB); G8_STAGE(G8_SA(1, 0), cA + kstep, voffA[0]); G8_STAGE(G8_SB(1, 1), cB + hstepB + kstep, voffB);
    G8_WAIT_V(6); G8_BAR;
    for (;;) {
        const bool has_next = S.next(ui + 1, nxt);
        const char* nA = has_next ? nxt.a : cA; const char* nB = has_next ? nxt.b : cB;
        if constexpr (GATHER) { if (has_next) { G8_ROWS(voffAn, nxt); } else {
#pragma unroll
            for (int h = 0; h < 2; ++h)
#pragma unroll
                for (int i = 0; i < 2; ++i) voffAn[h][i] = voffA[h][i]; } }
#pragma unroll 1
        for (int t = 0; t < nt; t += 2) {
            const bool last = (t == nt - 2);
            const char* a1 = cA + (size_t)(t + 1) * kstep;
            const char* a2 = last ? nA : cA + (size_t)(t + 2) * kstep; const char* b2 = last ? nB : cB + (size_t)(t + 2) * kstep;
            const char* a3 = a2 + kstep; const char* b3 = b2 + kstep;
            unsigned v2[2][2];
#pragma unroll
            for (int h = 0; h < 2; ++h)
#pragma unroll
                for (int i = 0; i < 2; ++i) v2[h][i] = (GATHER && last) ? voffAn[h][i] : voffA[h][i];
            G8_LDB(B0, 0, 0); G8_LDB(B1, 0, 1); G8_SCHED; G8_LDA(At, 0, 0); G8_STAGE(G8_SA(1, 1), a1, voffA[1]);
            G8_WAIT_V(8); G8_WAIT_L(0); G8_BAR; G8_MMA(0, 0, At, B0); G8_MMA(0, 1, At, B1); G8_BAR; G8_SCHED;
            G8_LDA(At, 0, 1); G8_STAGE(G8_SB(0, 0), b2, voffB); G8_STAGE(G8_SB(0, 1), b2 + hstepB, voffB); G8_STAGE(G8_SA(0, 0), a2, v2[0]);
            G8_WAIT_V(8); G8_WAIT_L(0); G8_BAR; G8_MMA(1, 0, At, B0); G8_MMA(1, 1, At, B1); G8_BAR; G8_SCHED;
            G8_LDB(B0, 1, 0); G8_LDB(B1, 1, 1); G8_SCHED; G8_LDA(At, 1, 0); G8_STAGE(G8_SA(0, 1), a2, v2[1]);
            G8_WAIT_V(8); G8_WAIT_L(0); G8_BAR; G8_MMA(0, 0, At, B0); G8_MMA(0, 1, At, B1); G8_BAR; G8_SCHED;
            G8_LDA(At, 1, 1); G8_STAGE(G8_SB(1, 0), b3, voffB); G8_STAGE(G8_SB(1, 1), b3 + hstepB, voffB); G8_STAGE(G8_SA(1, 0), a3, v2[0]);
            G8_WAIT_V(8); G8_WAIT_L(0); G8_BAR; G8_MMA(1, 0, At, B0); G8_MMA(1, 1, At, B1); G8_BAR; G8_SCHED;
        }
        if constexpr (ALIGN_EPI) { if (wr == 0) G8_BAR; }
        E(acc, cur, wr, wc, fr, fq);
        if (!has_next) break;
        E.init(acc, nxt, wr, wc, fr, fq);
        cur = nxt; cA = nA; cB = nB; ++ui;
        if constexpr (GATHER) {
#pragma unroll
            for (int h = 0; h < 2; ++h)
#pragma unroll
                for (int i = 0; i < 2; ++i) voffA[h][i] = voffAn[h][i]; }
        if constexpr (ALIGN_EPI) { if (wr == 1) G8_BAR; }
    }
    G8_WAIT_V(0);
    if constexpr (!ALIGN_EPI) { if (wr == 0) G8_BAR; }
    G8_BAR;
#undef G8_SA
#undef G8_SB
#undef G8_STAGE
#undef G8_LDA
#undef G8_LDB
#undef G8_MMA
#undef G8_WAIT_V
#undef G8_WAIT_L
#undef G8_BAR
#undef G8_SCHED
#undef G8_ROWS
}
__device__ __forceinline__ h16x8 pack8(const f32x4& a, const f32x4& b) { h16x8 r; r[0] = (h16)a[0]; r[1] = (h16)a[1]; r[2] = (h16)a[2]; r[3] = (h16)a[3]; r[4] = (h16)b[0]; r[5] = (h16)b[1]; r[6] = (h16)b[2]; r[7] = (h16)b[3]; return r; }
__device__ __forceinline__ void acc_zero(f32x4 (&acc)[2][2][4][2]) {
#pragma unroll
    for (int a = 0; a < 2; ++a)
#pragma unroll
        for (int b = 0; b < 2; ++b)
#pragma unroll
            for (int m = 0; m < 4; ++m)
#pragma unroll
                for (int n = 0; n < 2; ++n) acc[a][b][m][n] = (f32x4){0.f, 0.f, 0.f, 0.f};
}
struct EpiH { static constexpr bool PERM = true; h16* C; int ldc;
    __device__ __forceinline__ void init(f32x4 (&acc)[2][2][4][2], const Unit&, int, int, int, int) const { acc_zero(acc); }
    __device__ __forceinline__ void operator()(const f32x4 (&acc)[2][2][4][2], const Unit& u, int wr, int wc, int fr, int fq) const {
        const int row0 = u.pm * BM + wr * 64 + fr, col0 = u.pn * BM + wc * 32 + 8 * fq;
#pragma unroll
        for (int ai = 0; ai < 2; ++ai)
#pragma unroll
            for (int m = 0; m < 4; ++m) { h16* rowp = C + (size_t)(row0 + ai * HALF + m * 16) * ldc + col0;
#pragma unroll
                for (int bj = 0; bj < 2; ++bj) *(h16x8*)(rowp + bj * HALF) = pack8(acc[ai][bj][m][0], acc[ai][bj][m][1]); } } };
template <int MODE> struct EpiRes { static constexpr bool PERM = true; const float* Rf; const h16* Rh; h16* Yh; float* Yf;
    __device__ __forceinline__ void init(f32x4 (&acc)[2][2][4][2], const Unit&, int, int, int, int) const { acc_zero(acc); }
    __device__ __forceinline__ void operator()(const f32x4 (&acc)[2][2][4][2], const Unit& u, int wr, int wc, int fr, int fq) const {
        const int row0 = u.pm * BM + wr * 64 + fr, col0 = u.pn * BM + wc * 32 + 8 * fq;
        if constexpr (MODE != 0) {
            h16x8 r[2][4][2];
#pragma unroll
            for (int ai = 0; ai < 2; ++ai)
#pragma unroll
                for (int m = 0; m < 4; ++m) { const size_t ro = (size_t)(row0 + ai * HALF + m * 16) * DM + col0;
#pragma unroll
                    for (int bj = 0; bj < 2; ++bj) r[ai][m][bj] = *(const h16x8*)(Rh + ro + bj * HALF); }
#pragma unroll
            for (int ai = 0; ai < 2; ++ai)
#pragma unroll
                for (int m = 0; m < 4; ++m) { const size_t ro = (size_t)(row0 + ai * HALF + m * 16) * DM + col0;
#pragma unroll
                    for (int bj = 0; bj < 2; ++bj) { const h16x8 h = r[ai][m][bj];
                        const f32x4 v0 = (f32x4){(float)h[0], (float)h[1], (float)h[2], (float)h[3]} * ALPHA + acc[ai][bj][m][0], v1 = (f32x4){(float)h[4], (float)h[5], (float)h[6], (float)h[7]} * ALPHA + acc[ai][bj][m][1];
                        if constexpr (MODE == 2) { *(f32x4*)(Yf + ro + bj * HALF) = v0; *(f32x4*)(Yf + ro + bj * HALF + 4) = v1; }
                        else *(h16x8*)(Yh + ro + bj * HALF) = pack8(v0, v1); } }
        } else {
#pragma unroll
            for (int ai = 0; ai < 2; ++ai) {
                f32x4 r[4][2][2];
#pragma unroll
                for (int m = 0; m < 4; ++m) { const size_t ro = (size_t)(row0 + ai * HALF + m * 16) * DM + col0;
#pragma unroll
                    for (int bj = 0; bj < 2; ++bj) { r[m][bj][0] = *(const f32x4*)(Rf + ro + bj * HALF); r[m][bj][1] = *(const f32x4*)(Rf + ro + bj * HALF + 4); } }
#pragma unroll
                for (int m = 0; m < 4; ++m) { const size_t ro = (size_t)(row0 + ai * HALF + m * 16) * DM + col0;
#pragma unroll
                    for (int bj = 0; bj < 2; ++bj) *(h16x8*)(Yh + ro + bj * HALF) = pack8(r[m][bj][0] * ALPHA + acc[ai][bj][m][0], r[m][bj][1] * ALPHA + acc[ai][bj][m][1]); } } }
    } };
struct EpiResStat { static constexpr bool PERM = true; const h16* Rh; h16* Yh; f32x2* stat;
    __device__ __forceinline__ void init(f32x4 (&acc)[2][2][4][2], const Unit&, int, int, int, int) const { acc_zero(acc); }
    __device__ __forceinline__ void operator()(const f32x4 (&acc)[2][2][4][2], const Unit& u, int wr, int wc, int fr, int fq) const {
        const int row0 = u.pm * BM + wr * 64 + fr, col0 = u.pn * BM + wc * 32 + 8 * fq;
        h16x8 r[2][4][2];
#pragma unroll
        for (int ai = 0; ai < 2; ++ai)
#pragma unroll
            for (int m = 0; m < 4; ++m) { const size_t ro = (size_t)(row0 + ai * HALF + m * 16) * DM + col0;
#pragma unroll
                for (int bj = 0; bj < 2; ++bj) r[ai][m][bj] = *(const h16x8*)(Rh + ro + bj * HALF); }
#pragma unroll
        for (int ai = 0; ai < 2; ++ai)
#pragma unroll
            for (int m = 0; m < 4; ++m) { const int row = row0 + ai * HALF + m * 16; const size_t ro = (size_t)row * DM + col0; float s1 = 0.f, s2 = 0.f;
#pragma unroll
                for (int bj = 0; bj < 2; ++bj) { const h16x8 h = r[ai][m][bj];
                    const f32x4 v0 = (f32x4){(float)h[0], (float)h[1], (float)h[2], (float)h[3]} * ALPHA + acc[ai][bj][m][0], v1 = (f32x4){(float)h[4], (float)h[5], (float)h[6], (float)h[7]} * ALPHA + acc[ai][bj][m][1];
                    const h16x8 o = pack8(v0, v1); *(h16x8*)(Yh + ro + bj * HALF) = o;
#pragma unroll
                    for (int e = 0; e < 8; ++e) { const float f = (float)o[e]; s1 += f; s2 += f * f; } }
                s1 += shx(s1, 16); s2 += shx(s2, 16); s1 = half_sum(s1); s2 = half_sum(s2);
                if (fq == 0) stat[(size_t)row * 16 + u.pn * 4 + wc] = (f32x2){s1, s2}; } } };
struct EpiLnQ { static constexpr bool PERM = true; h16* C; int ldc; const f32x2* murs; const float* csbw;
    __device__ __forceinline__ void init(f32x4 (&acc)[2][2][4][2], const Unit&, int, int, int, int) const { acc_zero(acc); }
    __device__ __forceinline__ void operator()(const f32x4 (&acc)[2][2][4][2], const Unit& u, int wr, int wc, int fr, int fq) const {
        const int row0 = u.pm * BM + wr * 64 + fr, col0 = u.pn * BM + wc * 32 + 8 * fq;
        f32x4 cs[2][2], bw[2][2]; f32x2 mr[2][4];
#pragma unroll
        for (int bj = 0; bj < 2; ++bj)
#pragma unroll
            for (int n = 0; n < 2; ++n) { cs[bj][n] = *(const f32x4*)(csbw + col0 + bj * HALF + 4 * n); bw[bj][n] = *(const f32x4*)(csbw + 512 + col0 + bj * HALF + 4 * n); }
#pragma unroll
        for (int ai = 0; ai < 2; ++ai)
#pragma unroll
            for (int m = 0; m < 4; ++m) mr[ai][m] = murs[row0 + ai * HALF + m * 16];
#pragma unroll
        for (int ai = 0; ai < 2; ++ai)
#pragma unroll
            for (int m = 0; m < 4; ++m) { h16* rowp = C + (size_t)(row0 + ai * HALF + m * 16) * ldc + col0; const float mu = mr[ai][m][0], rs = mr[ai][m][1];
#pragma unroll
                for (int bj = 0; bj < 2; ++bj) *(h16x8*)(rowp + bj * HALF) = pack8((acc[ai][bj][m][0] - cs[bj][0] * mu) * rs + bw[bj][0], (acc[ai][bj][m][1] - cs[bj][1] * mu) * rs + bw[bj][1]); } } };
struct EpiResLn { static constexpr bool PERM = true; const h16* Rh; h16* Yh; const f32x2* murs; const float* g; const float* b;
    __device__ __forceinline__ void init(f32x4 (&acc)[2][2][4][2], const Unit&, int, int, int, int) const { acc_zero(acc); }
    __device__ __forceinline__ void operator()(const f32x4 (&acc)[2][2][4][2], const Unit& u, int wr, int wc, int fr, int fq) const {
        const int row0 = u.pm * BM + wr * 64 + fr, col0 = u.pn * BM + wc * 32 + 8 * fq;
        f32x4 g4[2][2], b4[2][2];
#pragma unroll
        for (int bj = 0; bj < 2; ++bj)
#pragma unroll
            for (int n = 0; n < 2; ++n) { g4[bj][n] = *(const f32x4*)(g + col0 + bj * HALF + 4 * n); b4[bj][n] = *(const f32x4*)(b + col0 + bj * HALF + 4 * n); }
#pragma unroll
        for (int ai = 0; ai < 2; ++ai) {
            h16x8 r[4][2]; f32x2 mr[4];
#pragma unroll
            for (int m = 0; m < 4; ++m) { const int row = row0 + ai * HALF + m * 16; const size_t ro = (size_t)row * DM + col0; mr[m] = murs[row];
#pragma unroll
                for (int bj = 0; bj < 2; ++bj) r[m][bj] = *(const h16x8*)(Rh + ro + bj * HALF); }
#pragma unroll
            for (int m = 0; m < 4; ++m) { const size_t ro = (size_t)(row0 + ai * HALF + m * 16) * DM + col0; const float mu = mr[m][0], rs = mr[m][1];
#pragma unroll
                for (int bj = 0; bj < 2; ++bj) { const h16x8 h = r[m][bj];
                    const f32x4 n0 = ((f32x4){(float)h[0], (float)h[1], (float)h[2], (float)h[3]} - mu) * rs * g4[bj][0] + b4[bj][0], n1 = ((f32x4){(float)h[4], (float)h[5], (float)h[6], (float)h[7]} - mu) * rs * g4[bj][1] + b4[bj][1];
                    *(h16x8*)(Yh + ro + bj * HALF) = pack8(n0 * ALPHA + acc[ai][bj][m][0], n1 * ALPHA + acc[ai][bj][m][1]); } } } } };
struct EpiGU { static constexpr bool PERM = false; h16* Hs; const float* roww;
    __device__ __forceinline__ void init(f32x4 (&acc)[2][2][4][2], const Unit&, int, int, int, int) const { acc_zero(acc); }
    __device__ __forceinline__ void operator()(const f32x4 (&acc)[2][2][4][2], const Unit& u, int wr, int wc, int fr, int fq) const {
        const int row0 = u.pm * BM + wr * 64 + fr, hc0 = u.pn * 128 + wc * 32 + 8 * fq;
        float w[2][4];
#pragma unroll
        for (int ai = 0; ai < 2; ++ai)
#pragma unroll
            for (int m = 0; m < 4; ++m) w[ai][m] = roww ? roww[row0 + ai * HALF + m * 16] : 1.f;
#pragma unroll
        for (int ai = 0; ai < 2; ++ai)
#pragma unroll
            for (int m = 0; m < 4; ++m) { const int row = row0 + ai * HALF + m * 16; h16x8 o;
#pragma unroll
                for (int bj = 0; bj < 2; ++bj) { const f32x4 g = acc[ai][bj][m][0], up = acc[ai][bj][m][1];
#pragma unroll
                    for (int j = 0; j < 4; ++j) o[4 * bj + j] = (h16)(g[j] * __builtin_amdgcn_rcpf(1.f + __expf(-g[j])) * up[j] * w[ai][m]); }
                *(h16x8*)(Hs + (size_t)row * EDIM + hc0) = o; } } };
constexpr float YSCALE = 16.f;
__device__ __forceinline__ unsigned pk4_fp8(const f32x4& v) {
    const float a = __builtin_amdgcn_fmed3f(v[0] * YSCALE, -448.f, 448.f), b = __builtin_amdgcn_fmed3f(v[1] * YSCALE, -448.f, 448.f),
                c = __builtin_amdgcn_fmed3f(v[2] * YSCALE, -448.f, 448.f), d = __builtin_amdgcn_fmed3f(v[3] * YSCALE, -448.f, 448.f);
    int w = 0; w = __builtin_amdgcn_cvt_pk_fp8_f32(a, b, w, false); w = __builtin_amdgcn_cvt_pk_fp8_f32(c, d, w, true); return (unsigned)w; }
struct EpiDn { static constexpr bool PERM = false; unsigned char* Y8; const int* rowdst;
    __device__ __forceinline__ void init(f32x4 (&acc)[2][2][4][2], const Unit&, int, int, int, int) const { acc_zero(acc); }
    __device__ __forceinline__ void operator()(const f32x4 (&acc)[2][2][4][2], const Unit& u, int wr, int wc, int fr, int fq) const {
        const int row0 = u.pm * BM + wr * 64 + fr, col0 = u.pn * BM + wc * 64 + 16 * fq;
        int d[2][4];
#pragma unroll
        for (int ai = 0; ai < 2; ++ai)
#pragma unroll
            for (int m = 0; m < 4; ++m) d[ai][m] = rowdst[row0 + ai * HALF + m * 16];
#pragma unroll
        for (int ai = 0; ai < 2; ++ai)
#pragma unroll
            for (int m = 0; m < 4; ++m) { typedef unsigned u32x4_ __attribute__((ext_vector_type(4)));
                const u32x4_ w = {pk4_fp8(acc[ai][0][m][0]), pk4_fp8(acc[ai][0][m][1]), pk4_fp8(acc[ai][1][m][0]), pk4_fp8(acc[ai][1][m][1])};
                *(u32x4_*)(Y8 + (size_t)d[ai][m] * DM + col0) = w; } } };
}
__device__ __forceinline__ void ph_murs(const g8::DenseOrder& S, const f32x2* __restrict__ stat, f32x2* __restrict__ murs) {
    g8::Unit u; const int tid = tid_fresh();
    for (int i = 0; S.next(i, u); ++i) if (tid < 256) {
        const int row = u.pm * 256 + tid; const f32x4* p = (const f32x4*)(stat + (size_t)row * 16);
        float s1 = 0.f, s2 = 0.f;
#pragma unroll
        for (int q = 0; q < 8; ++q) { const f32x4 v = p[q]; s1 += v[0]; s2 += v[1]; s1 += v[2]; s2 += v[3]; }
        const float mu = s1 * (1.f / DM), var = s2 * (1.f / DM) - mu * mu;
        murs[row] = (f32x2){mu, rsqrtf((var > 0.f ? var : 0.f) + LN_EPS)};
    }
    asm volatile("s_waitcnt vmcnt(0)" ::: "memory"); __syncthreads();
}
__device__ __forceinline__ int ph_tile_map(LAS int* t2e, const int* __restrict__ off) {
    const int tid = tid_fresh(); const int ntile = off[NE] >> 8;
    LAS int* ob = t2e + 640;
    __syncthreads();
    if (tid < NE) ob[tid] = off[tid + 1];
    __syncthreads();
    for (int rt = tid; rt < ntile; rt += NTHR) { const int target = rt * 256; int e = 0;
#pragma unroll
        for (int step = 32; step > 0; step >>= 1) if (e + step <= NE - 1 && ob[e + step - 1] <= target) e += step;
        t2e[rt] = e; }
    __syncthreads();
    return ntile;
}

namespace fa {
typedef short s16x4 __attribute__((ext_vector_type(4)));
typedef unsigned u32x4 __attribute__((ext_vector_type(4)));
#define FA_SBAR() __builtin_amdgcn_sched_barrier(0)
constexpr float THR = 8.f;
template <int MODE> struct Cfg {
    static constexpr int DQK = MODE == 0 ? 64 : (MODE == 1 ? 192 : 128), NQ = DQK / 16, ROWB = DQK * 2, SHM_K = 64 * ROWB, SHM_V = 64 * 128 * 2, SDEPTH = MODE == 1 ? 1 : 2;
    static constexpr float SCALE = MODE == 0 ? 0.125f : (MODE == 1 ? 0.07216878364870322f : 0.08838834764831845f);
    static constexpr int NKP = MODE == 0 ? 1 : (MODE == 1 ? 3 : 2);
};
template <int MODE> __device__ __forceinline__ int kswz(int row, int c) {
    if (MODE == 2) return row * 256 + ((c ^ (row & 15)) << 4);
    return row * Cfg<MODE>::ROWB + (((c & ~7) | ((c & 7) ^ ((row >> 1) & 7))) << 4);
}
__device__ __forceinline__ unsigned cvtpk(float lo, float hi) { f32x2 v = {lo, hi}; h16x2 h = __builtin_convertvector(v, h16x2); return __builtin_bit_cast(unsigned, h); }
__device__ __forceinline__ int v_st(int k, int c) { const int kk = (k & ~0xC) | ((k & 4) << 1) | ((k & 8) >> 1); return ((kk >> 3) * 4 + (c >> 5)) * 512 + ((kk & 7) * 32 + (c & 31)) * 2; }
__device__ __forceinline__ int v_rd_base(int lane) { return ((lane & 3) << 3) | (((lane >> 2) & 3) << 6) | (((lane >> 4) & 1) << 5) | (((lane >> 5) & 1) << 8); }
constexpr int v_rd_off(int d0, int ks, int half) { return d0 * 512 + ks * 4096 + half * 2048; }
template <int OFF> __device__ __forceinline__ s16x4 tr_read(int vb) { s16x4 r; asm volatile("ds_read_b64_tr_b16 %0, %1 offset:%2" : "=&v"(r) : "v"(vb), "i"(OFF) : "memory"); return r; }
template <int D0> __device__ __forceinline__ void pv_one(f32x16& od, int vb, h16x8 pa0, h16x8 pa1, h16x8 pa2, h16x8 pa3) {
    const s16x4 l0 = tr_read<v_rd_off(D0, 0, 0)>(vb), h0 = tr_read<v_rd_off(D0, 0, 1)>(vb), l1 = tr_read<v_rd_off(D0, 1, 0)>(vb), h1 = tr_read<v_rd_off(D0, 1, 1)>(vb);
    const s16x4 l2 = tr_read<v_rd_off(D0, 2, 0)>(vb), h2 = tr_read<v_rd_off(D0, 2, 1)>(vb), l3 = tr_read<v_rd_off(D0, 3, 0)>(vb), h3 = tr_read<v_rd_off(D0, 3, 1)>(vb);
    asm volatile("s_waitcnt lgkmcnt(0)" ::: "memory"); FA_SBAR();
#define FA_PK(L, H) __builtin_bit_cast(h16x8, (short __attribute__((ext_vector_type(8)))){L[0], L[1], L[2], L[3], H[0], H[1], H[2], H[3]})
    od = __builtin_amdgcn_mfma_f32_32x32x16_f16(pa0, FA_PK(l0, h0), od, 0, 0, 0);
    od = __builtin_amdgcn_mfma_f32_32x32x16_f16(pa1, FA_PK(l1, h1), od, 0, 0, 0);
    od = __builtin_amdgcn_mfma_f32_32x32x16_f16(pa2, FA_PK(l2, h2), od, 0, 0, 0);
    od = __builtin_amdgcn_mfma_f32_32x32x16_f16(pa3, FA_PK(l3, h3), od, 0, 0, 0);
#undef FA_PK
}
__device__ __forceinline__ void pv_d0(f32x16* o, int vb, h16x8 pa0, h16x8 pa1, h16x8 pa2, h16x8 pa3) {
    pv_one<0>(o[0], vb, pa0, pa1, pa2, pa3); pv_one<1>(o[1], vb, pa0, pa1, pa2, pa3); pv_one<2>(o[2], vb, pa0, pa1, pa2, pa3); pv_one<3>(o[3], vb, pa0, pa1, pa2, pa3);
}
template <int MODE> __device__ __forceinline__ void partialSM(f32x16& p0, f32x16& p1, float& m_reg, float& mn, float& alpha) {
    constexpr float C = Cfg<MODE>::SCALE * LOG2E;
    float pmax = p0[0];
#pragma unroll
    for (int r = 1; r < 16; ++r) pmax = fmaxf(pmax, p0[r]);
#pragma unroll
    for (int r = 0; r < 16; ++r) pmax = fmaxf(pmax, p1[r]);
    { auto rr = __builtin_amdgcn_permlane32_swap(__float_as_uint(pmax), __float_as_uint(pmax), false, false); pmax = fmaxf(__uint_as_float(rr[0]), __uint_as_float(rr[1])); }
    if (__builtin_expect(__all(pmax - m_reg <= THR / Cfg<MODE>::SCALE), 1)) { mn = m_reg; alpha = 1.f; }
    else { mn = fmaxf(m_reg, pmax); alpha = __builtin_amdgcn_exp2f((m_reg - mn) * C); m_reg = mn; }
    const float mnC = -mn * C;
#pragma unroll
    for (int r = 0; r < 16; ++r) p0[r] = fmaf(p0[r], C, mnC);
#pragma unroll
    for (int r = 0; r < 16; ++r) p1[r] = fmaf(p1[r], C, mnC);
#pragma unroll
    for (int r = 0; r < 16; ++r) p0[r] = __builtin_amdgcn_exp2f(p0[r]);
}
__device__ __forceinline__ void finishSM(f32x16& p0, f32x16& p1, float alpha, float& l_reg, h16x8& pa0, h16x8& pa1, h16x8& pa2, h16x8& pa3) {
#pragma unroll
    for (int r = 0; r < 16; ++r) p1[r] = __builtin_amdgcn_exp2f(p1[r]);
    float ps = 0;
#pragma unroll
    for (int r = 0; r < 16; ++r) ps += p0[r];
#pragma unroll
    for (int r = 0; r < 16; ++r) ps += p1[r];
    { auto rr = __builtin_amdgcn_permlane32_swap(__float_as_uint(ps), __float_as_uint(ps), false, false); ps = __uint_as_float(rr[0]) + __uint_as_float(rr[1]); }
    l_reg = l_reg * alpha + ps;
#define FA_PK4(P, BASE, OUT) do { unsigned a0 = cvtpk(P[BASE + 0], P[BASE + 1]), a1 = cvtpk(P[BASE + 2], P[BASE + 3]); \
    unsigned b0 = cvtpk(P[BASE + 4], P[BASE + 5]), b1 = cvtpk(P[BASE + 6], P[BASE + 7]); \
    auto r0 = __builtin_amdgcn_permlane32_swap(a0, b0, false, false); auto r1 = __builtin_amdgcn_permlane32_swap(a1, b1, false, false); \
    u32x4 w = {r0[0], r1[0], r0[1], r1[1]}; OUT = __builtin_bit_cast(h16x8, w); } while (0)
    FA_PK4(p0, 0, pa0); FA_PK4(p0, 8, pa1); FA_PK4(p1, 0, pa2); FA_PK4(p1, 8, pa3);
#undef FA_PK4
}
template <int MODE> __device__ __forceinline__ void qkt(f32x16& p0, f32x16& p1, const char* Ks, const h16x8* qr, const char* qpe, int r32, int hi) {
    p0 = f32x16{}; p1 = f32x16{};
#pragma unroll
    for (int d0 = 0; d0 < Cfg<MODE>::NQ; ++d0) {
        const h16x8 b0 = *reinterpret_cast<const h16x8*>(Ks + kswz<MODE>(r32, 2 * d0 + hi));
        const h16x8 b1 = *reinterpret_cast<const h16x8*>(Ks + kswz<MODE>(32 + r32, 2 * d0 + hi));
        const h16x8 qf = (MODE == 1 && d0 >= 5) ? *reinterpret_cast<const h16x8*>(qpe + (d0 - 5) * 1024) : qr[d0];
        p0 = __builtin_amdgcn_mfma_f32_32x32x16_f16(b0, qf, p0, 0, 0, 0);
        p1 = __builtin_amdgcn_mfma_f32_32x32x16_f16(b1, qf, p1, 0, 0, 0); }
}
__device__ __forceinline__ void cmask(f32x16& p0, f32x16& p1, int kb0, int qrel, int hi) {
    const int kb = kb0 + 4 * hi;
#pragma unroll
    for (int r = 0; r < 16; ++r) { const int kv = kb + (r & 3) + 8 * (r >> 2); if (kv > qrel) p0[r] = -INFINITY; if (kv + 32 > qrel) p1[r] = -INFINITY; }
}
template <int MODE>
__device__ __forceinline__ void attn_unit(const h16* __restrict__ Qg, int ldq, const h16* __restrict__ Kg, int ldk, const h16* __restrict__ Kg2, int ldk2, const h16* __restrict__ Vg, int ldv,
                                          h16* __restrict__ Og, int ldo, int nkeys, int q0, char* lds, int epi, const float* __restrict__ gain, float lam, const float* __restrict__ ropeq) {
    using C = Cfg<MODE>; constexpr int NQ = C::NQ, SHM_K = C::SHM_K, SHM_V = C::SHM_V, SDEPTH = C::SDEPTH;
    const int tid = tid_fresh(), wid = tid >> 6, lane = tid & 63, r32 = lane & 31, hi = lane >> 5;
    char* V_lds = lds; char* K_lds = lds + 2 * SHM_V;
    float* wsf = (float*)(lds + 2 * SHM_V + 2 * SHM_K) + wid * 64; float* li_l = wsf; float* al_l = wsf + 32;
    float m_reg = -1e30f, l_reg = 0; f32x16 o[4] = {}; h16x8 qr[NQ];
    const h16* Qw = Qg + (size_t)(wid * 32 + r32) * ldq + hi * 8;
#pragma unroll
    for (int d0 = 0; d0 < NQ; ++d0) qr[d0] = *reinterpret_cast<const h16x8*>(Qw + d0 * 16);
    if constexpr (MODE == 1) {
        const float* cr = ropeq + (size_t)(wid * 32 + r32) * 32 + 8 * hi; const float* sr_ = cr + (size_t)T * 32;
#pragma unroll
        for (int blk = 0; blk < 2; ++blk) { const f32x8 c8 = *(const f32x8*)(cr + 16 * blk), s8 = *(const f32x8*)(sr_ + 16 * blk);
#pragma unroll
            for (int j = 0; j < 8; ++j) { const float x1 = (float)qr[8 + blk][j], x2 = (float)qr[10 + blk][j];
                qr[8 + blk][j] = (h16)(x1 * c8[j] - x2 * s8[j]); qr[10 + blk][j] = (h16)(x2 * c8[j] + x1 * s8[j]); } }
    }
    char* qpe = lds + 84 * 1024 + wid * 7168 + lane * 16;
    if constexpr (MODE == 1) {
#pragma unroll
        for (int f = 0; f < 7; ++f) *reinterpret_cast<h16x8*>(qpe + f * 1024) = qr[5 + f];
    }
    if constexpr (MODE == 0) {
        const float* cr = ropeq + (size_t)(wid * 32 + r32) * 8 + 4 * hi; const f32x4 c4 = *(const f32x4*)cr, s4 = *(const f32x4*)(cr + (size_t)T * 8);
#pragma unroll
        for (int j = 0; j < 4; ++j) { const float x1 = (float)qr[0][j], x2 = (float)qr[0][4 + j]; qr[0][j] = (h16)(x1 * c4[j] - x2 * s4[j]); qr[0][4 + j] = (h16)(x2 * c4[j] + x1 * s4[j]); }
    }
    const int sr = tid >> 4, sc = (tid & 15) * 8, vst0 = v_st(sr, sc), vst1 = v_st(32 + sr, sc);
    const int kr8 = tid >> 3, kc8 = tid & 7;
    const int vb0 = (int)(uintptr_t)V_lds + v_rd_base(lane);
    struct { h16x8 vs0, vs1, k0, k1, k2; } st[SDEPTH];
#define FA_SLOAD(i, key0) do { st[i].vs0 = *(const h16x8*)(Vg + (size_t)((key0) + sr) * ldv + sc); st[i].vs1 = *(const h16x8*)(Vg + (size_t)((key0) + 32 + sr) * ldv + sc); \
        if (MODE == 0) { st[i].k0 = *(const h16x8*)(Kg + (size_t)((key0) + kr8) * ldk + kc8 * 8); } \
        else { st[i].k0 = *(const h16x8*)(Kg + (size_t)((key0) + sr) * ldk + sc); st[i].k1 = *(const h16x8*)(Kg + (size_t)((key0) + 32 + sr) * ldk + sc); \
               if (MODE == 1) st[i].k2 = *(const h16x8*)(Kg2 + (size_t)((key0) + kr8) * ldk2 + kc8 * 8); } } while (0)
#define FA_SWRITE(b, i) do { *(h16x8*)(V_lds + (b) * SHM_V + vst0) = st[i].vs0; *(h16x8*)(V_lds + (b) * SHM_V + vst1) = st[i].vs1; \
        if (MODE == 0) { *(h16x8*)(K_lds + (b) * SHM_K + kswz<MODE>(kr8, kc8)) = st[i].k0; } \
        else { *(h16x8*)(K_lds + (b) * SHM_K + kswz<MODE>(sr, tid & 15)) = st[i].k0; *(h16x8*)(K_lds + (b) * SHM_K + kswz<MODE>(32 + sr, tid & 15)) = st[i].k1; \
               if (MODE == 1) *(h16x8*)(K_lds + (b) * SHM_K + kswz<MODE>(kr8, 16 + kc8)) = st[i].k2; } } while (0)
#define FA_SWAIT() do { if constexpr (SDEPTH == 2) { if (MODE == 0) asm volatile("s_waitcnt vmcnt(3)" ::: "memory"); else asm volatile("s_waitcnt vmcnt(4)" ::: "memory"); } else asm volatile("s_waitcnt vmcnt(0)" ::: "memory"); } while (0)
#define FA_RESC(a) do { if (__any((a) < 1.f)) { if (hi == 0) al_l[r32] = (a); asm volatile("s_waitcnt lgkmcnt(0)" ::: "memory"); \
        _Pragma("unroll") for (int d = 0; d < 4; ++d) _Pragma("unroll") for (int r = 0; r < 16; ++r) o[d][r] *= al_l[crow(r, hi)]; } } while (0)
#define FA_MASK(P0, P1, j) do { if (MODE != 2) { const int kb0_ = (j) * 64 - q0; if (kb0_ + 63 > wid * 32) cmask(P0, P1, kb0_, wid * 32 + r32, hi); } } while (0)
    h16x8 pa0, pa1, pa2, pa3; const int NT = nkeys / 64;
    f32x16 pA0, pA1, pB0, pB1; float mnA, mnB, alA, alB;
    constexpr int SE = 0, SO = SDEPTH - 1;
    FA_SLOAD(SE, 0); asm volatile("s_waitcnt vmcnt(0)" ::: "memory"); FA_SWRITE(0, SE); __syncthreads();
    qkt<MODE>(pA0, pA1, K_lds, qr, qpe, r32, hi); FA_MASK(pA0, pA1, 0); partialSM<MODE>(pA0, pA1, m_reg, mnA, alA);
    FA_SLOAD(SO, 64); if constexpr (SDEPTH == 2) { if (2 < NT) FA_SLOAD(SE, 128); }
    FA_SWAIT(); FA_SWRITE(1, SO); __syncthreads();
    for (int j = 1; j + 1 < NT; j += 2) {
        FA_SBAR(); qkt<MODE>(pB0, pB1, K_lds + SHM_K, qr, qpe, r32, hi); FA_MASK(pB0, pB1, j);
        finishSM(pA0, pA1, alA, l_reg, pa0, pa1, pa2, pa3); FA_SBAR();
        FA_SLOAD(SO, (j + SDEPTH) * 64); FA_SBAR();
        pv_d0(o, vb0, pa0, pa1, pa2, pa3); partialSM<MODE>(pB0, pB1, m_reg, mnB, alB);
        __syncthreads(); FA_SWAIT(); FA_SWRITE(0, SE);
        FA_RESC(alB); __syncthreads();
        FA_SBAR(); qkt<MODE>(pA0, pA1, K_lds, qr, qpe, r32, hi); FA_MASK(pA0, pA1, j + 1);
        finishSM(pB0, pB1, alB, l_reg, pa0, pa1, pa2, pa3); FA_SBAR();
        if (SDEPTH == 1 || j + 3 < NT) FA_SLOAD(SE, (j + 1 + SDEPTH) * 64); FA_SBAR();
        pv_d0(o, vb0 + SHM_V, pa0, pa1, pa2, pa3); partialSM<MODE>(pA0, pA1, m_reg, mnA, alA);
        __syncthreads(); FA_SWAIT(); FA_SWRITE(1, SO);
        FA_RESC(alA); __syncthreads();
    }
    const int tid_t = tid_fresh(), lane_t = tid_t & 63, wid_t = tid_t >> 6, r32_t = lane_t & 31, hi_t = lane_t >> 5;
    char* qpe_t = lds + 84 * 1024 + wid_t * 7168 + lane_t * 16; const int vb0_t = (int)(uintptr_t)V_lds + v_rd_base(lane_t);
    float* al_t = (float*)(lds + 2 * SHM_V + 2 * SHM_K) + wid_t * 64 + 32;
    FA_SBAR(); qkt<MODE>(pB0, pB1, K_lds + SHM_K, qr, qpe_t, r32_t, hi_t);
    if (MODE != 2) { const int kb0_ = (NT - 1) * 64 - q0; if (kb0_ + 63 > wid_t * 32) cmask(pB0, pB1, kb0_, wid_t * 32 + r32_t, hi_t); }
    finishSM(pA0, pA1, alA, l_reg, pa0, pa1, pa2, pa3); FA_SBAR();
    pv_d0(o, vb0_t, pa0, pa1, pa2, pa3); partialSM<MODE>(pB0, pB1, m_reg, mnB, alB);
    __syncthreads();
    if (__any(alB < 1.f)) { if (hi_t == 0) al_t[r32_t] = alB; asm volatile("s_waitcnt lgkmcnt(0)" ::: "memory");
#pragma unroll
        for (int d = 0; d < 4; ++d)
#pragma unroll
            for (int r = 0; r < 16; ++r) o[d][r] *= al_t[crow(r, hi_t)]; }
    finishSM(pB0, pB1, alB, l_reg, pa0, pa1, pa2, pa3); FA_SBAR();
    pv_d0(o, vb0_t + SHM_V, pa0, pa1, pa2, pa3);
    const int tid_e = tid_fresh(), lane_e = tid_e & 63, wid_e = tid_e >> 6, r32_e = lane_e & 31, hi_e = lane_e >> 5;
    float* li_e = (float*)(lds + 2 * SHM_V + 2 * SHM_K) + wid_e * 64;
    if (hi_e == 0) li_e[r32_e] = l_reg; asm volatile("s_waitcnt lgkmcnt(0)" ::: "memory");
    float rli[16];
#pragma unroll
    for (int r = 0; r < 16; ++r) rli[r] = __builtin_amdgcn_rcpf(li_e[crow(r, hi_e)]);
    __syncthreads();
    constexpr int STASH = 72 * 1024;
    char* stg = lds + ((MODE == 0 && epi == 0) ? STASH : 0) + wid_e * (32 * 272);
#pragma unroll
    for (int r = 0; r < 16; ++r) { const int orow = crow(r, hi_e);
#pragma unroll
        for (int d0 = 0; d0 < 4; ++d0) *(h16*)(stg + orow * 272 + (d0 * 32 + r32_e) * 2) = (h16)(o[d0][r] * rli[r]); }
    asm volatile("s_waitcnt lgkmcnt(0)" ::: "memory");
    if (!(MODE == 0 && epi == 0)) {
        h16* Ow = Og + (size_t)(wid_e * 32) * ldo; const int ch = lane_e & 15;
        f32x8 g8v; if constexpr (MODE != 2) g8v = *(const f32x8*)(gain + ch * 8);
#pragma unroll
        for (int i = 0; i < 8; ++i) { const int row = i * 4 + (lane_e >> 4);
            if constexpr (MODE == 2) { *(u32x4*)(Ow + (size_t)row * ldo + ch * 8) = *(const u32x4*)(stg + row * 272 + ch * 16); }
            else {
                const h16x8 a = *(const h16x8*)(stg + row * 272 + ch * 16); float v[8];
                if constexpr (MODE == 0) { const h16x8 a1 = *(const h16x8*)(lds + STASH + wid_e * (32 * 272) + row * 272 + ch * 16);
#pragma unroll
                    for (int e = 0; e < 8; ++e) v[e] = (float)a1[e] - lam * (float)a[e]; }
                else {
#pragma unroll
                    for (int e = 0; e < 8; ++e) v[e] = (float)a[e]; }
                float ss = 0.f;
#pragma unroll
                for (int e = 0; e < 8; ++e) ss += v[e] * v[e];
                ss += shx(ss, 1); ss += shx(ss, 2); ss += shx(ss, 4); ss += shx(ss, 8);
                const float rs = rsqrtf(ss * (1.f / 128.f) + RMS_EPS) * (MODE == 0 ? 0.8f : 1.f); h16x8 ov;
#pragma unroll
                for (int e = 0; e < 8; ++e) ov[e] = (h16)(v[e] * rs * g8v[e]);
                *(h16x8*)(Ow + (size_t)row * ldo + ch * 8) = ov; } }
    }
    __syncthreads();
#undef FA_SLOAD
#undef FA_SWRITE
#undef FA_SWAIT
#undef FA_RESC
#undef FA_MASK
}
}
namespace fd {
typedef short s16x4 __attribute__((ext_vector_type(4)));
typedef short v4i16_t __attribute__((ext_vector_type(4)));
typedef unsigned u32x4 __attribute__((ext_vector_type(4)));
typedef __attribute__((address_space(3))) const char* lds_cptr;
#define FD_SBAR() __builtin_amdgcn_sched_barrier(0)
constexpr int NSLK = 4, NSLV = 3, KSLOT = 8192, VSLOT = 16384;
constexpr int LDS_K = 0, LDS_V = NSLK * KSLOT, LDS_WS = LDS_V + NSLV * VSLOT, LDS_STASH = LDS_WS + 2048, LDS_END = LDS_STASH + 8 * 32 * 272;
constexpr float C2 = 0.125f * LOG2E;
__device__ __forceinline__ void glds16(const void* gsrc, unsigned lds_dst) { unsigned keep;
    asm volatile("s_mov_b32 %0, m0\n\ts_mov_b32 m0, %2\n\ts_nop 0\n\tglobal_load_lds_dwordx4 %1, off\n\ts_mov_b32 m0, %0" : "=&s"(keep) : "v"(gsrc), "s"(lds_dst) : "memory"); }
__device__ __forceinline__ float max3f(float a, float b, float c) { float r; asm("v_max3_f32 %0, %1, %2, %3" : "=v"(r) : "v"(a), "v"(b), "v"(c)); return r; }
__device__ __forceinline__ float max2f(float a, float b) { float r; asm("v_max_f32_e32 %0, %1, %2" : "=v"(r) : "v"(a), "v"(b)); return r; }
__device__ __forceinline__ float fadd_s(float a, float b) { float r; asm("v_add_f32_e32 %0, %1, %2" : "=v"(r) : "v"(a), "v"(b)); return r; }
__device__ __forceinline__ float fsub_s(float a, float b) { float r; asm("v_sub_f32_e32 %0, %1, %2" : "=v"(r) : "v"(a), "v"(b)); return r; }
__device__ __forceinline__ unsigned cvtpk_s(float lo, float hi) { f32x2 v = {lo, hi}; h16x2 h = __builtin_convertvector(v, h16x2); return __builtin_bit_cast(unsigned, h); }
#define FD_WAIT_BAR(N) asm volatile("s_waitcnt vmcnt(" #N ") lgkmcnt(0)\n\ts_barrier" ::: "memory")
__device__ __forceinline__ void qkt(f32x16& p0, f32x16& p1, const char* Kslot, const h16x8* qr, int r32, int hi) {
    const f32x16 negm = f32x16{};
    const char* kb = Kslot + hi * 1024 + r32 * 16;
#pragma unroll
    for (int d0 = 0; d0 < 4; ++d0) {
        const h16x8 b0 = *reinterpret_cast<const h16x8*>(kb + d0 * 2048);
        const h16x8 b1 = *reinterpret_cast<const h16x8*>(kb + d0 * 2048 + 512);
        if (d0 == 0) { p0 = __builtin_amdgcn_mfma_f32_32x32x16_f16(b0, qr[0], negm, 0, 0, 0); p1 = __builtin_amdgcn_mfma_f32_32x32x16_f16(b1, qr[0], negm, 0, 0, 0); }
        else { p0 = __builtin_amdgcn_mfma_f32_32x32x16_f16(b0, qr[d0], p0, 0, 0, 0); p1 = __builtin_amdgcn_mfma_f32_32x32x16_f16(b1, qr[d0], p1, 0, 0, 0); } }
}
__device__ __forceinline__ void kload8(h16x8* kf, lds_cptr kp) {
    kf[0] = *(const __attribute__((address_space(3))) h16x8*)(kp);        kf[1] = *(const __attribute__((address_space(3))) h16x8*)(kp + 512);
    kf[2] = *(const __attribute__((address_space(3))) h16x8*)(kp + 2048); kf[3] = *(const __attribute__((address_space(3))) h16x8*)(kp + 2560);
    kf[4] = *(const __attribute__((address_space(3))) h16x8*)(kp + 4096); kf[5] = *(const __attribute__((address_space(3))) h16x8*)(kp + 4608);
    kf[6] = *(const __attribute__((address_space(3))) h16x8*)(kp + 6144); kf[7] = *(const __attribute__((address_space(3))) h16x8*)(kp + 6656);
}
__device__ __forceinline__ void kload2(h16x8* kf, lds_cptr kp, int j) { kf[2 * j] = *(const __attribute__((address_space(3))) h16x8*)(kp + j * 2048); kf[2 * j + 1] = *(const __attribute__((address_space(3))) h16x8*)(kp + j * 2048 + 512); }
__device__ __forceinline__ s16x4 vtr(lds_cptr p) { return __builtin_bit_cast(s16x4, __builtin_amdgcn_ds_read_tr16_b64_v4i16((__attribute__((address_space(3))) v4i16_t*)p)); }
__device__ __forceinline__ void pv(f32x16* o, int vb, h16x8 pa0, h16x8 pa1, h16x8 pa2, h16x8 pa3) {
#pragma unroll
    for (int d0 = 0; d0 < 4; ++d0) { s16x4 lo[4], hi[4];
#pragma unroll
        for (int ks = 0; ks < 4; ++ks) {
            asm volatile("ds_read_b64_tr_b16 %0,%1 offset:%c2" : "=&v"(lo[ks]) : "v"(vb), "i"(d0 * 4096 + ks * 1024) : "memory");
            asm volatile("ds_read_b64_tr_b16 %0,%1 offset:%c2" : "=&v"(hi[ks]) : "v"(vb), "i"(d0 * 4096 + ks * 1024 + 512) : "memory"); }
        asm volatile("s_waitcnt lgkmcnt(0)" ::: "memory"); FD_SBAR();
#define FD_PK(k) __builtin_bit_cast(h16x8, (short __attribute__((ext_vector_type(8)))){lo[k][0], lo[k][1], lo[k][2], lo[k][3], hi[k][0], hi[k][1], hi[k][2], hi[k][3]})
        o[d0] = __builtin_amdgcn_mfma_f32_32x32x16_f16(pa0, FD_PK(0), o[d0], 0, 0, 0);
        o[d0] = __builtin_amdgcn_mfma_f32_32x32x16_f16(pa1, FD_PK(1), o[d0], 0, 0, 0);
        o[d0] = __builtin_amdgcn_mfma_f32_32x32x16_f16(pa2, FD_PK(2), o[d0], 0, 0, 0);
        o[d0] = __builtin_amdgcn_mfma_f32_32x32x16_f16(pa3, FD_PK(3), o[d0], 0, 0, 0);
#undef FD_PK
    }
}
__device__ __forceinline__ char* ptab_abs(int i) { const volatile LAS unsigned* t = (const volatile LAS unsigned*)(LDS_PTAB) + 2 * i; const unsigned lo = __builtin_amdgcn_readfirstlane(t[0]), hi = __builtin_amdgcn_readfirstlane(t[1]);
    return (char*)(__attribute__((address_space(1))) char*)(((unsigned long long)hi << 32) | (unsigned long long)lo); }
template <int THRL>
__device__ __forceinline__ void attn_unit(int qoff, int koff, int voff, int ooff, int roff, int q0, char* shm, int epi, float lam) {
    const int tid = tid_fresh(), lane = tid & 63, r32 = lane & 31, hi = lane >> 5; const int wid = __builtin_amdgcn_readfirstlane(tid >> 6);
    const unsigned lds0 = (unsigned)(uintptr_t)shm;
    float* wsf = (float*)(shm + LDS_WS) + wid * 64;
    const h16* PROJp = (const h16*)(ptab_abs(34) + WS_PROJ);
    const h16* ksrc = PROJp + koff + (size_t)lane * NPROJ + wid * 8;
    const h16* vsrc = PROJp + voff + (size_t)(16 * (wid & 3) + (lane >> 2)) * NPROJ + (wid >> 2) * 32 + (lane & 3) * 8;
    const unsigned kdst = lds0 + LDS_K + wid * 1024, vdst = lds0 + LDS_V + wid * 1024;
#define FD_DMA_K(t, slot) glds16(ksrc + (size_t)(t) * 64 * NPROJ, (unsigned)__builtin_amdgcn_readfirstlane(kdst + (slot)))
#define FD_DMA_V(t, slot) do { glds16(vsrc + (size_t)(t) * 64 * NPROJ, (unsigned)__builtin_amdgcn_readfirstlane(vdst + (slot))); \
                               glds16(vsrc + (size_t)(t) * 64 * NPROJ + 64, (unsigned)__builtin_amdgcn_readfirstlane(vdst + (slot) + 8192)); } while (0)
    const int vb0 = (int)(lds0 + LDS_V) + ((lane >> 4) & 1) * 32 + (lane & 3) * 8 + (4 * hi + ((lane & 15) >> 2)) * 64;
    const char* Kbase = shm + LDS_K; h16x8 kf[8];
    const lds_cptr shm3 = (lds_cptr)shm; const lds_cptr kp0 = shm3 + LDS_K + hi * 1024 + r32 * 16;
    const lds_cptr vp0 = shm3 + LDS_V + ((lane >> 4) & 1) * 32 + (lane & 3) * 8 + (4 * hi + ((lane & 15) >> 2)) * 64;
    const int NT = (q0 + 256) / 64;
    FD_DMA_K(0, 0); FD_DMA_V(0, 0); FD_DMA_K(1, KSLOT);
    h16x8 qr[4];
    { const h16* Qw = PROJp + qoff + (size_t)(wid * 32 + r32) * NPROJ + hi * 8;
#pragma unroll
      for (int d0 = 0; d0 < 4; ++d0) qr[d0] = *reinterpret_cast<const h16x8*>(Qw + d0 * 16);
      const float* cr = (const float*)(ptab_abs(34) + WS_ROPE) + (size_t)(roff + wid * 32 + r32) * 8 + 4 * hi; const f32x4 c4 = *(const f32x4*)cr, s4 = *(const f32x4*)(cr + (size_t)T * 8);
#pragma unroll
      for (int j = 0; j < 4; ++j) { const float x1 = (float)qr[0][j], x2 = (float)qr[0][4 + j]; qr[0][j] = (h16)((x1 * c4[j] - x2 * s4[j]) * C2); qr[0][4 + j] = (h16)((x2 * c4[j] + x1 * s4[j]) * C2); }
#pragma unroll
      for (int d0 = 1; d0 < 4; ++d0)
#pragma unroll
          for (int j = 0; j < 8; ++j) qr[d0][j] = (h16)((float)qr[d0][j] * C2); }
    float mhat = 0.f, l_reg = 0.f; f32x16 o[4]; o[0] = f32x16{}; o[1] = f32x16{}; o[2] = f32x16{}; o[3] = f32x16{}; f32x16 negm = f32x16{}; asm volatile("" : "+v"(negm));
    const int qrel = wid * 32 + r32;
#define FD_CMASK(P0, P1, t) do { const int jb_ = (t) - (NT - 4); if (jb_ >= 0) { const int k0_ = 64 * jb_, w0_ = wid * 32;     \
        if (k0_ + 63 > w0_) { if (k0_ > w0_ + 31) { _Pragma("unroll") for (int r_ = 0; r_ < 16; ++r_) { P0[r_] = -INFINITY; P1[r_] = -INFINITY; } } else fa::cmask(P0, P1, k0_, qrel, hi); } } } while (0)
    bool resc = false;
#define FD_START(P0, P1) do { mhat = rowmax_(P0, P1); resc = false; \
    _Pragma("unroll") for (int r = 0; r < 16; ++r) { P0[r] = fsub_s(P0[r], mhat); P1[r] = fsub_s(P1[r], mhat); } \
    _Pragma("unroll") for (int r = 0; r < 16; ++r) negm[r] = -mhat; asm volatile("" : "+v"(negm)); \
    _Pragma("unroll") for (int r = 0; r < 16; ++r) P0[r] = __builtin_amdgcn_exp2f(P0[r]); } while (0)
#define FD_RESC() do { if (resc) { asm volatile("s_waitcnt lgkmcnt(0)" ::: "memory"); \
      _Pragma("unroll") for (int d_ = 0; d_ < 4; ++d_) _Pragma("unroll") for (int r = 0; r < 16; ++r) o[d_][r] *= wsf[crow(r, hi)]; } } while (0)
    auto rowmax_ = [&](const f32x16& p0, const f32x16& p1) -> float {
        float a = max3f(p0[0], p0[1], p1[0]), b = max3f(p0[2], p0[3], p1[1]); a = max3f(a, p1[2], p1[3]);
#pragma unroll
        for (int r = 4; r < 16; r += 4) { a = max3f(a, p0[r], p0[r + 1]); b = max3f(b, p0[r + 2], p0[r + 3]); a = max3f(a, p1[r], p1[r + 1]); b = max3f(b, p1[r + 2], p1[r + 3]); }
        const float m = max2f(a, b);
        auto rr = __builtin_amdgcn_permlane32_swap(__float_as_uint(m), __float_as_uint(m), false, false);
        return max2f(__uint_as_float(rr[0]), __uint_as_float(rr[1])); };
    f32x16 pA0, pA1, pB0, pB1;
    int sl_prev = 0, sl_cur = 0, sl_next = VSLOT;
#define FD_ROT() do { sl_prev = sl_cur; sl_cur = sl_next; sl_next = (sl_next == (NSLV - 1) * VSLOT) ? 0 : sl_next + VSLOT; } while (0)
#define FD_KS(t) (((t) & 3) * KSLOT)
    FD_DMA_K(2, 2 * KSLOT);
    FD_WAIT_BAR(4);
    qkt(pA0, pA1, Kbase, qr, r32, hi); asm volatile("s_nop 15\n\ts_nop 7" : "+v"(pA0), "+v"(pA1)); FD_CMASK(pA0, pA1, 0);
    FD_START(pA0, pA1);
#pragma unroll
    for (int r = 0; r < 16; ++r) pA1[r] = __builtin_amdgcn_exp2f(pA1[r]);
    { float s0 = 0.f;
#pragma unroll
      for (int r = 0; r < 16; r += 2) { s0 += pA0[r]; s0 += pA1[r]; }
      l_reg = s0; }
    FD_WAIT_BAR(0);
    FD_DMA_K(3, 3 * KSLOT); FD_DMA_V(1, VSLOT);
    FD_ROT();
    kload2(kf, kp0 + KSLOT, 0); kload2(kf, kp0 + KSLOT, 1);
    FD_WAIT_BAR(3);
    s16x4 vlo[16], vhi[16]; u32x4 pw0, pw1, pw2, pw3;
#define FD_PKW(P, B) cvtpk_s(P[B], P[B + 1])
#define FD_PAF(k) __builtin_bit_cast(h16x8, pw##k)
#define FD_VFR(i) __builtin_bit_cast(h16x8, (short __attribute__((ext_vector_type(8)))){vlo[i][0], vlo[i][1], vlo[i][2], vlo[i][3], vhi[i][0], vhi[i][1], vhi[i][2], vhi[i][3]})
#define FD_PIN(x) asm volatile("" : "+v"(x))
#define FD_MX3(a, b, c) __builtin_fmaxf(__builtin_fmaxf((a), (b)), (c))
#define FD_GAPA(MF, A0, A1, W0, W1, PW) do { MF; sacc += A0; sacc += A1; FD_PIN(sacc); W0; W1; FD_PIN(PW); FD_SBAR(); } while (0)
#define FD_EX(v) __builtin_amdgcn_exp2f(v)
#define FD_GAPB(MF, X, B) do { MF; X[B] = FD_EX(X[B]); X[B + 1] = FD_EX(X[B + 1]); sB += X[B]; FD_PIN(sB); FD_PIN(X); FD_SBAR(); } while (0)
#define FD_VRD(g) do { vlo[g] = vtr(vp_ + (((g) & 3) * 4096 + ((g) >> 2) * 1024)); vhi[g] = vtr(vp_ + (((g) & 3) * 4096 + ((g) >> 2) * 1024 + 512)); } while (0)
#define FD_KRD(G, j, t) do { if (G) { kload2(kf, kp0 + FD_KS((t) + 1), j); FD_SBAR(); } } while (0)
#define FD_KR1(i, t) do { kf[i] = *(const __attribute__((address_space(3))) h16x8*)(kp0 + FD_KS(t) + ((i) >> 1) * 2048 + ((i) & 1) * 512); FD_SBAR(); } while (0)
#define FD_PVM(g, ks) o[(g) & 3] = __builtin_amdgcn_mfma_f32_32x32x16_f16(FD_PAF(ks), FD_VFR(g), o[(g) & 3], 0, 0, 0)
#define FD_STEP(C0, C1, P0, P1, t, GK, GV, GL) do { FD_SBAR(); \
    const lds_cptr vp_ = vp0 + sl_prev; \
    float sacc = P0[1]; \
    FD_KR1(4, t); FD_GAPA(C0 = __builtin_amdgcn_mfma_f32_32x32x16_f16(kf[0], qr[0], negm, 0, 0, 0), P0[3], P0[5],     pw0[0] = FD_PKW(P0, 0), pw0[1] = FD_PKW(P0, 2), pw0); \
    FD_KR1(5, t); FD_GAPA(C1 = __builtin_amdgcn_mfma_f32_32x32x16_f16(kf[1], qr[0], negm, 0, 0, 0), P0[7], P0[9],     pw0[2] = FD_PKW(P0, 4), pw0[3] = FD_PKW(P0, 6), pw0); \
    FD_KR1(6, t); FD_GAPA(C0 = __builtin_amdgcn_mfma_f32_32x32x16_f16(kf[2], qr[1], C0, 0, 0, 0),   P0[11], P0[13], pw1[0] = FD_PKW(P0, 8), pw1[1] = FD_PKW(P0, 10), pw1); \
    FD_KR1(7, t); FD_GAPA(C1 = __builtin_amdgcn_mfma_f32_32x32x16_f16(kf[3], qr[1], C1, 0, 0, 0),   P0[15], P1[1],   pw1[2] = FD_PKW(P0, 12), pw1[3] = FD_PKW(P0, 14), pw1); \
    FD_VRD(0); FD_SBAR(); FD_GAPA(C0 = __builtin_amdgcn_mfma_f32_32x32x16_f16(kf[4], qr[2], C0, 0, 0, 0),   P1[3], P1[5],     pw2[0] = FD_PKW(P1, 0), pw2[1] = FD_PKW(P1, 2), pw2); \
    FD_VRD(1); FD_SBAR(); FD_GAPA(C1 = __builtin_amdgcn_mfma_f32_32x32x16_f16(kf[5], qr[2], C1, 0, 0, 0),   P1[7], P1[9],     pw2[2] = FD_PKW(P1, 4), pw2[3] = FD_PKW(P1, 6), pw2); \
    FD_VRD(2); FD_SBAR(); FD_GAPA(C0 = __builtin_amdgcn_mfma_f32_32x32x16_f16(kf[6], qr[3], C0, 0, 0, 0),   P1[11], P1[13], pw3[0] = FD_PKW(P1, 8), pw3[1] = FD_PKW(P1, 10), pw3); \
    FD_VRD(3); FD_SBAR(); FD_GAPA(C1 = __builtin_amdgcn_mfma_f32_32x32x16_f16(kf[7], qr[3], C1, 0, 0, 0),   P1[15], 0.f,       pw3[2] = FD_PKW(P1, 12), pw3[3] = FD_PKW(P1, 14), pw3); \
    l_reg += sacc; \
    if (GK) { FD_DMA_K((t) + 3, FD_KS((t) + 3)); } if (GV) { FD_DMA_V((t) + 1, sl_next); } \
    FD_CMASK(C0, C1, t); \
    { float a = FD_MX3(C0[0], C0[1], C1[0]), b = FD_MX3(C0[2], C0[3], C1[1]); a = FD_MX3(a, C1[2], C1[3]); \
      _Pragma("unroll") for (int r = 4; r < 16; r += 4) { a = FD_MX3(a, C0[r], C0[r + 1]); b = FD_MX3(b, C0[r + 2], C0[r + 3]); a = FD_MX3(a, C1[r], C1[r + 1]); b = FD_MX3(b, C1[r + 2], C1[r + 3]); } \
      float rm = __builtin_fmaxf(a, b); { auto rr = __builtin_amdgcn_permlane32_swap(__float_as_uint(rm), __float_as_uint(rm), false, false); rm = __builtin_fmaxf(__uint_as_float(rr[0]), __uint_as_float(rr[1])); } \
      resc = false; \
      if (__builtin_expect(__any(rm > (float)THRL), 0)) { const float dl = __builtin_fmaxf(rm, 0.f); mhat += dl; \
        _Pragma("unroll") for (int r = 0; r < 16; ++r) { C0[r] -= dl; C1[r] -= dl; } \
        _Pragma("unroll") for (int r = 0; r < 16; ++r) negm[r] = -mhat; asm volatile("" : "+v"(negm)); \
        const float f = __builtin_amdgcn_exp2f(-dl); l_reg *= f; if (hi == 0) wsf[r32] = f; resc = true; } } \
    float sB = 0.f; FD_SBAR(); \
    FD_GAPB(FD_PVM(0, 0), C0, 0);   FD_VRD(4);  FD_SBAR(); \
    FD_GAPB(FD_PVM(1, 0), C0, 2);   FD_VRD(5);  FD_SBAR(); \
    FD_GAPB(FD_PVM(2, 0), C0, 4);   FD_VRD(6);  FD_SBAR(); \
    FD_GAPB(FD_PVM(3, 0), C0, 6);   FD_VRD(7);  FD_SBAR(); \
    FD_GAPB(FD_PVM(4, 1), C0, 8);   FD_VRD(8);  FD_SBAR(); \
    FD_GAPB(FD_PVM(5, 1), C0, 10);  FD_VRD(9);  FD_SBAR(); \
    FD_GAPB(FD_PVM(6, 1), C0, 12);  FD_VRD(10); FD_SBAR(); \
    FD_GAPB(FD_PVM(7, 1), C0, 14);  FD_VRD(11); FD_SBAR(); \
    FD_GAPB(FD_PVM(8, 2), C1, 0);   FD_VRD(12); FD_SBAR(); \
    FD_GAPB(FD_PVM(9, 2), C1, 2);   FD_VRD(13); FD_SBAR(); \
    FD_GAPB(FD_PVM(10, 2), C1, 4);  FD_VRD(14); FD_SBAR(); \
    FD_GAPB(FD_PVM(11, 2), C1, 6);  FD_VRD(15); FD_SBAR(); \
    FD_KRD(GL, 0, t); FD_GAPB(FD_PVM(12, 3), C1, 8); \
    FD_KRD(GL, 1, t); FD_GAPB(FD_PVM(13, 3), C1, 10); \
    FD_GAPB(FD_PVM(14, 3), C1, 12); \
    FD_GAPB(FD_PVM(15, 3), C1, 14); \
    l_reg += sB; \
    } while (0)
    int t = 1;
#undef FD_CMASK
#define FD_CMASK(P0, P1, t) do { } while (0)
    for (; t + 5 < NT; t += 2) {
        FD_STEP(pB0, pB1, pA0, pA1, t, true, true, true);     FD_WAIT_BAR(3); FD_RESC(); FD_ROT();
        FD_STEP(pA0, pA1, pB0, pB1, t + 1, true, true, true); FD_WAIT_BAR(3); FD_RESC(); FD_ROT();
    }
#undef FD_CMASK
#define FD_CMASK(P0, P1, t) do { const int jb_ = (t) - (NT - 4); if (jb_ >= 0) { const int k0_ = 64 * jb_, w0_ = wid * 32;     \
        if (k0_ + 63 > w0_) { if (k0_ > w0_ + 31) { _Pragma("unroll") for (int r_ = 0; r_ < 16; ++r_) { P0[r_] = -INFINITY; P1[r_] = -INFINITY; } } else fa::cmask(P0, P1, k0_, qrel, hi); } } } while (0)
#define FD_ENDW(tt) do { if ((tt) + 3 < NT) { FD_WAIT_BAR(3); } else if ((tt) + 2 < NT) { FD_WAIT_BAR(2); } else { FD_WAIT_BAR(0); } } while (0)
    for (; t + 1 < NT; t += 2) {
        FD_STEP(pB0, pB1, pA0, pA1, t, (t + 3 < NT), (t + 1 < NT), (t + 1 < NT));         FD_ENDW(t);     FD_RESC(); FD_ROT();
        FD_STEP(pA0, pA1, pB0, pB1, t + 1, (t + 4 < NT), (t + 2 < NT), (t + 2 < NT));     FD_ENDW(t + 1); FD_RESC(); FD_ROT();
    }
    FD_STEP(pB0, pB1, pA0, pA1, NT - 1, false, false, false); FD_RESC();
    { float sacc = 0.f;
#pragma unroll
      for (int r = 1; r < 16; r += 2) { sacc += pB0[r]; sacc += pB1[r]; }
      l_reg += sacc;
      pw0 = (u32x4){FD_PKW(pB0, 0), FD_PKW(pB0, 2), FD_PKW(pB0, 4), FD_PKW(pB0, 6)}; pw1 = (u32x4){FD_PKW(pB0, 8), FD_PKW(pB0, 10), FD_PKW(pB0, 12), FD_PKW(pB0, 14)};
      pw2 = (u32x4){FD_PKW(pB1, 0), FD_PKW(pB1, 2), FD_PKW(pB1, 4), FD_PKW(pB1, 6)}; pw3 = (u32x4){FD_PKW(pB1, 8), FD_PKW(pB1, 10), FD_PKW(pB1, 12), FD_PKW(pB1, 14)};
      FD_SBAR(); pv(o, vb0 + sl_cur, FD_PAF(0), FD_PAF(1), FD_PAF(2), FD_PAF(3)); }
    { auto rr = __builtin_amdgcn_permlane32_swap(__float_as_uint(l_reg), __float_as_uint(l_reg), false, false); l_reg = __uint_as_float(rr[0]) + __uint_as_float(rr[1]); }
    if (hi == 0) wsf[32 + r32] = l_reg; asm volatile("s_waitcnt lgkmcnt(0)" ::: "memory");
    float rli[16];
#pragma unroll
    for (int r = 0; r < 16; ++r) rli[r] = __builtin_amdgcn_rcpf(wsf[32 + crow(r, hi)]);
    if (epi) asm volatile("s_waitcnt lgkmcnt(0)\n\ts_barrier" ::: "memory");
    char* stg = shm + (epi ? 0 : LDS_STASH) + wid * (32 * 272);
#pragma unroll
    for (int r = 0; r < 16; ++r) { const int orow = crow(r, hi);
#pragma unroll
        for (int d0 = 0; d0 < 4; ++d0) *(h16*)(stg + orow * 272 + (d0 * 32 + r32) * 2) = (h16)(o[d0][r] * rli[r]); }
    asm volatile("s_waitcnt lgkmcnt(0)" ::: "memory");
    if (epi) {
        h16* Ow = (h16*)(ptab_abs(34) + WS_MIX) + ooff + (size_t)(wid * 32) * 1024; const int ch = lane & 15;
        const f32x8 g8v = *(const f32x8*)((const float*)ptab_abs(8) + ch * 8);
#pragma unroll
        for (int i = 0; i < 8; ++i) { const int row = i * 4 + (lane >> 4);
            const h16x8 a = *(const h16x8*)(stg + row * 272 + ch * 16); const h16x8 a1 = *(const h16x8*)(shm + LDS_STASH + wid * (32 * 272) + row * 272 + ch * 16); float v[8];
#pragma unroll
            for (int e = 0; e < 8; ++e) v[e] = (float)a1[e] - lam * (float)a[e];
            float ss = 0.f;
#pragma unroll
            for (int e = 0; e < 8; ++e) ss += v[e] * v[e];
            ss += shx(ss, 1); ss += shx(ss, 2); ss += shx(ss, 4); ss += shx(ss, 8);
            const float rs = rsqrtf(ss * (1.f / 128.f) + RMS_EPS) * 0.8f; h16x8 ov;
#pragma unroll
            for (int e = 0; e < 8; ++e) ov[e] = (h16)(v[e] * rs * g8v[e]);
            *(h16x8*)(Ow + (size_t)row * 1024 + ch * 8) = ov; }
    }
    asm volatile("s_waitcnt lgkmcnt(0)\n\ts_barrier" ::: "memory");
#undef FD_DMA_K
#undef FD_DMA_V
#undef FD_CMASK
#undef FD_START
#undef FD_RESC
#undef FD_ROT
#undef FD_PKW
#undef FD_PAF
#undef FD_VFR
#undef FD_PIN
#undef FD_MX3
#undef FD_GAPA
#undef FD_GAPB
#undef FD_EX
#undef FD_VRD
#undef FD_KRD
#undef FD_KR1
#undef FD_KS
#undef FD_PVM
#undef FD_STEP
#undef FD_ENDW
}
#undef FD_SBAR
#undef FD_WAIT_BAR
}
namespace fm {
using fd::s16x4; using fd::u32x4; using fd::lds_cptr; using fd::v4i16_t;
#define FM_SBAR() __builtin_amdgcn_sched_barrier(0)
constexpr int KSLOT = 24576, VSLOT = 16384;
constexpr int LDS_K = 0, LDS_V = 3 * KSLOT, LDS_WS = LDS_V + 3 * VSLOT, LDS_Q = LDS_WS + 2048, LDS_END = LDS_Q + 8 * 4096;
static_assert(LDS_END <= LDS_BYTES - 1024, "fm LDS map");
constexpr float C2 = 0.07216878364870322f * LOG2E;
#define FM_WAIT_BAR(N) asm volatile("s_waitcnt vmcnt(" #N ") lgkmcnt(0)\n\ts_barrier" ::: "memory")
typedef const __attribute__((address_space(3))) h16x8* lds_h8;
template <int THRL>
__device__ __forceinline__ void attn_unit(int t0, int h, int q0, char* shm) {
    const int tid = tid_fresh(), lane = tid & 63, r32 = lane & 31, hi = lane >> 5; const int wid = __builtin_amdgcn_readfirstlane(tid >> 6);
    const unsigned lds0 = (unsigned)(uintptr_t)shm;
    float* wsf = (float*)(shm + LDS_WS) + wid * 64;
    const h16* QKVMp = (const h16*)(fd::ptab_abs(34) + WS_QKVM); const h16* PROJp = (const h16*)(fd::ptab_abs(34) + WS_PROJ);
    const h16* ksrcn = QKVMp + (size_t)t0 * NUP + 768 + h * 256 + (size_t)lane * NUP + wid * 8;
    const h16* ksrcr = PROJp + (size_t)t0 * NPROJ + C_KR + (size_t)lane * NPROJ + wid * 8;
    const h16* vsrc = QKVMp + (size_t)t0 * NUP + 768 + h * 256 + 128 + (size_t)(16 * (wid & 3) + (lane >> 2)) * NUP + (wid >> 2) * 32 + (lane & 3) * 8;
    const unsigned kdst = lds0 + LDS_K + wid * 1024, vdst = lds0 + LDS_V + wid * 1024;
#define FM_DMA_K(t, koff) do { const unsigned d_ = (unsigned)__builtin_amdgcn_readfirstlane(kdst + (koff)); \
        fd::glds16(ksrcn + (size_t)(t) * 64 * NUP, d_); fd::glds16(ksrcn + (size_t)(t) * 64 * NUP + 64, d_ + 8192); fd::glds16(ksrcr + (size_t)(t) * 64 * NPROJ, d_ + 16384); } while (0)
#define FM_DMA_V(t, voff) do { const unsigned d_ = (unsigned)__builtin_amdgcn_readfirstlane(vdst + (voff)); \
        fd::glds16(vsrc + (size_t)(t) * 64 * NUP, d_); fd::glds16(vsrc + (size_t)(t) * 64 * NUP + 64, d_ + 8192); } while (0)
    const int vb0 = (int)(lds0 + LDS_V) + ((lane >> 4) & 1) * 32 + (lane & 3) * 8 + (4 * hi + ((lane & 15) >> 2)) * 64;
    const lds_cptr shm3 = (lds_cptr)shm; const lds_cptr kp0 = shm3 + LDS_K + hi * 1024 + r32 * 16;
    const lds_cptr vp0 = shm3 + LDS_V + ((lane >> 4) & 1) * 32 + (lane & 3) * 8 + (4 * hi + ((lane & 15) >> 2)) * 64;
    const lds_cptr qp0 = shm3 + LDS_Q + wid * 4096 + lane * 16;
    const int NT = (q0 + 256) / 64;
    FM_DMA_K(0, 0); FM_DMA_V(0, 0); FM_DMA_K(1, KSLOT); FM_DMA_K(2, 2 * KSLOT);
    h16x8 qr[8];
    { const h16* Qw = QKVMp + (size_t)(t0 + q0 + wid * 32 + r32) * NUP + h * 192 + hi * 8; h16x8 qt[4];
#pragma unroll
      for (int d0 = 0; d0 < 8; ++d0) qr[d0] = *reinterpret_cast<const h16x8*>(Qw + d0 * 16);
#pragma unroll
      for (int d0 = 0; d0 < 4; ++d0) qt[d0] = *reinterpret_cast<const h16x8*>(Qw + (8 + d0) * 16);
      const float* cr = (const float*)(fd::ptab_abs(34) + WS_ROPE) + (size_t)T * 16 + (size_t)(t0 + q0 + wid * 32 + r32) * 32 + 8 * hi; const float* sr_ = cr + (size_t)T * 32;
#pragma unroll
      for (int blk = 0; blk < 2; ++blk) { const f32x8 c8 = *(const f32x8*)(cr + 16 * blk), s8 = *(const f32x8*)(sr_ + 16 * blk);
#pragma unroll
          for (int j = 0; j < 8; ++j) { const float x1 = (float)qt[blk][j], x2 = (float)qt[2 + blk][j];
              qt[blk][j] = (h16)((x1 * c8[j] - x2 * s8[j]) * C2); qt[2 + blk][j] = (h16)((x2 * c8[j] + x1 * s8[j]) * C2); } }
#pragma unroll
      for (int d0 = 0; d0 < 8; ++d0)
#pragma unroll
          for (int j = 0; j < 8; ++j) qr[d0][j] = (h16)((float)qr[d0][j] * C2);
#pragma unroll
      for (int d0 = 0; d0 < 4; ++d0) *(h16x8*)(shm + LDS_Q + wid * 4096 + lane * 16 + d0 * 1024) = qt[d0]; }
    float mhat = 0.f, l_reg = 0.f; f32x16 o[4]; o[0] = f32x16{}; o[1] = f32x16{}; o[2] = f32x16{}; o[3] = f32x16{}; const f32x16 zero16 = f32x16{}; f32x16 negm = f32x16{}; asm volatile("" : "+v"(negm));
    const int qrel = wid * 32 + r32;
#define FM_CMASK(P0, P1, t) do { const int jb_ = (t) - (NT - 4); if (jb_ >= 0) { const int k0_ = 64 * jb_, w0_ = wid * 32;     \
        if (k0_ + 63 > w0_) { if (k0_ > w0_ + 31) { _Pragma("unroll") for (int r_ = 0; r_ < 16; ++r_) { P0[r_] = -INFINITY; P1[r_] = -INFINITY; } } else fa::cmask(P0, P1, k0_, qrel, hi); } } } while (0)
    bool resc = false;
#define FM_RESC() do { if (resc) { asm volatile("s_waitcnt lgkmcnt(0)" ::: "memory"); \
      _Pragma("unroll") for (int d_ = 0; d_ < 4; ++d_) _Pragma("unroll") for (int r = 0; r < 16; ++r) o[d_][r] *= wsf[crow(r, hi)]; } } while (0)
    f32x16 pA0, pA1, pB0, pB1;
    int sl_prev = 0, sl_cur = 0, sl_next = VSLOT;
#define FM_ROT() do { sl_prev = sl_cur; sl_cur = sl_next; sl_next = (sl_next == 2 * VSLOT) ? 0 : sl_next + VSLOT; } while (0)
#define FM_KO(v) ((v) + ((v) >> 1))
    FM_WAIT_BAR(0);
    { pA0 = zero16; pA1 = zero16; const char* kb = shm + LDS_K + hi * 1024 + r32 * 16;
#pragma unroll
      for (int d0 = 0; d0 < 12; ++d0) { const h16x8 b0 = *reinterpret_cast<const h16x8*>(kb + d0 * 2048), b1 = *reinterpret_cast<const h16x8*>(kb + d0 * 2048 + 512);
          const h16x8 qf = d0 < 8 ? qr[d0 < 8 ? d0 : 0] : *reinterpret_cast<const h16x8*>(shm + LDS_Q + wid * 4096 + lane * 16 + (d0 - 8) * 1024);
          pA0 = __builtin_amdgcn_mfma_f32_32x32x16_f16(b0, qf, pA0, 0, 0, 0); pA1 = __builtin_amdgcn_mfma_f32_32x32x16_f16(b1, qf, pA1, 0, 0, 0); } }
    asm volatile("s_nop 15\n\ts_nop 7" : "+v"(pA0), "+v"(pA1)); FM_CMASK(pA0, pA1, 0);
    { float a = fd::max3f(pA0[0], pA0[1], pA1[0]), b = fd::max3f(pA0[2], pA0[3], pA1[1]); a = fd::max3f(a, pA1[2], pA1[3]);
#pragma unroll
      for (int r = 4; r < 16; r += 4) { a = fd::max3f(a, pA0[r], pA0[r + 1]); b = fd::max3f(b, pA0[r + 2], pA0[r + 3]); a = fd::max3f(a, pA1[r], pA1[r + 1]); b = fd::max3f(b, pA1[r + 2], pA1[r + 3]); }
      const float m = fd::max2f(a, b); auto rr = __builtin_amdgcn_permlane32_swap(__float_as_uint(m), __float_as_uint(m), false, false);
      mhat = fd::max2f(__uint_as_float(rr[0]), __uint_as_float(rr[1])); }
#pragma unroll
    for (int r = 0; r < 16; ++r) { pA0[r] = __builtin_amdgcn_exp2f(fd::fsub_s(pA0[r], mhat)); pA1[r] = __builtin_amdgcn_exp2f(fd::fsub_s(pA1[r], mhat)); }
#pragma unroll
    for (int r = 0; r < 16; ++r) negm[r] = -mhat;
    asm volatile("" : "+v"(negm));
    FM_WAIT_BAR(0);
    FM_DMA_V(1, VSLOT);
    FM_ROT();
    h16x8 kf[24]; h16x8 ql[4];
    kf[0] = *(lds_h8)(kp0 + KSLOT); kf[1] = *(lds_h8)(kp0 + KSLOT + 512); kf[2] = *(lds_h8)(kp0 + KSLOT + 2048);
    FM_WAIT_BAR(2);
    s16x4 vlo[16], vhi[16]; u32x4 pw0, pw1, pw2, pw3;
#define FM_PKW(P, B) fd::cvtpk_s(P[B], P[B + 1])
#define FM_PAF(k) __builtin_bit_cast(h16x8, pw##k)
#define FM_VFR(i) __builtin_bit_cast(h16x8, (short __attribute__((ext_vector_type(8)))){vlo[i][0], vlo[i][1], vlo[i][2], vlo[i][3], vhi[i][0], vhi[i][1], vhi[i][2], vhi[i][3]})
#define FM_PIN(x) asm volatile("" : "+v"(x))
#define FM_MX3(a, b, c) __builtin_fmaxf(__builtin_fmaxf((a), (b)), (c))
#define FM_EX(v) __builtin_amdgcn_exp2f(v)
#define FM_GAPB(MF, X, B) do { MF; X[B] = FM_EX(X[B]); X[B + 1] = FM_EX(X[B + 1]); FM_PIN(X); FM_SBAR(); } while (0)
#define FM_VRD(g) do { vlo[g] = fd::vtr(vp_ + (((g) & 3) * 4096 + ((g) >> 2) * 1024)); vhi[g] = fd::vtr(vp_ + (((g) & 3) * 4096 + ((g) >> 2) * 1024 + 512)); } while (0)
#define FM_KR(i, ko) do { kf[i] = *(lds_h8)(kp0 + (ko) + ((i) >> 1) * 2048 + ((i) & 1) * 512); } while (0)
#define FM_QL(d) do { ql[(d) - 8] = *(lds_h8)(qp0 + ((d) - 8) * 1024); } while (0)
#define FM_PVM(g, ks) o[(g) & 3] = __builtin_amdgcn_mfma_f32_32x32x16_f16(FM_PAF(ks), FM_VFR(g), o[(g) & 3], 0, 0, 0)
#define FM_STEP(C0, C1, P0, P1, t, GK, GV, GL) do { FM_SBAR(); \
    if (GK) { FM_DMA_K((t) + 2, FM_KO(sl_prev)); } if (GV) { FM_DMA_V((t) + 1, sl_next); } \
    const lds_cptr vp_ = vp0 + sl_prev; const int kc_ = FM_KO(sl_cur); \
    float sacc = 0.f; \
    FM_KR(3, kc_); FM_SBAR(); C0 = __builtin_amdgcn_mfma_f32_32x32x16_f16(kf[0], qr[0], negm, 0, 0, 0); sacc += P0[0]; sacc += P0[1]; FM_PIN(sacc); pw0[0] = FM_PKW(P0, 0); FM_PIN(pw0); FM_SBAR(); \
    FM_KR(4, kc_); FM_SBAR(); C1 = __builtin_amdgcn_mfma_f32_32x32x16_f16(kf[1], qr[0], negm, 0, 0, 0); sacc += P0[2]; sacc += P0[3]; FM_PIN(sacc); pw0[1] = FM_PKW(P0, 2); FM_PIN(pw0); FM_SBAR(); \
    FM_KR(5, kc_); FM_SBAR(); C0 = __builtin_amdgcn_mfma_f32_32x32x16_f16(kf[2], qr[1], C0, 0, 0, 0); sacc += P0[4]; sacc += P0[5]; FM_PIN(sacc); pw0[2] = FM_PKW(P0, 4); FM_PIN(pw0); FM_SBAR(); \
    FM_KR(6, kc_); FM_SBAR(); C1 = __builtin_amdgcn_mfma_f32_32x32x16_f16(kf[3], qr[1], C1, 0, 0, 0); sacc += P0[6]; sacc += P0[7]; FM_PIN(sacc); pw0[3] = FM_PKW(P0, 6); FM_PIN(pw0); FM_SBAR(); \
    FM_KR(7, kc_); FM_SBAR(); C0 = __builtin_amdgcn_mfma_f32_32x32x16_f16(kf[4], qr[2], C0, 0, 0, 0); sacc += P0[8]; sacc += P0[9]; FM_PIN(sacc); pw1[0] = FM_PKW(P0, 8); FM_PIN(pw1); FM_SBAR(); \
    FM_KR(8, kc_); FM_SBAR(); C1 = __builtin_amdgcn_mfma_f32_32x32x16_f16(kf[5], qr[2], C1, 0, 0, 0); sacc += P0[10]; sacc += P0[11]; FM_PIN(sacc); pw1[1] = FM_PKW(P0, 10); FM_PIN(pw1); FM_SBAR(); \
    FM_KR(9, kc_); FM_SBAR(); C0 = __builtin_amdgcn_mfma_f32_32x32x16_f16(kf[6], qr[3], C0, 0, 0, 0); sacc += P0[12]; sacc += P0[13]; FM_PIN(sacc); pw1[2] = FM_PKW(P0, 12); FM_PIN(pw1); FM_SBAR(); \
    FM_KR(10, kc_); FM_SBAR(); C1 = __builtin_amdgcn_mfma_f32_32x32x16_f16(kf[7], qr[3], C1, 0, 0, 0); sacc += P0[14]; sacc += P0[15]; FM_PIN(sacc); pw1[3] = FM_PKW(P0, 14); FM_PIN(pw1); FM_SBAR(); \
    FM_KR(11, kc_); FM_SBAR(); C0 = __builtin_amdgcn_mfma_f32_32x32x16_f16(kf[8], qr[4], C0, 0, 0, 0); sacc += P1[0]; sacc += P1[1]; FM_PIN(sacc); pw2[0] = FM_PKW(P1, 0); FM_PIN(pw2); FM_SBAR(); \
    FM_KR(12, kc_); FM_SBAR(); C1 = __builtin_amdgcn_mfma_f32_32x32x16_f16(kf[9], qr[4], C1, 0, 0, 0); sacc += P1[2]; sacc += P1[3]; FM_PIN(sacc); pw2[1] = FM_PKW(P1, 2); FM_PIN(pw2); FM_SBAR(); \
    FM_KR(13, kc_); FM_SBAR(); C0 = __builtin_amdgcn_mfma_f32_32x32x16_f16(kf[10], qr[5], C0, 0, 0, 0); sacc += P1[4]; sacc += P1[5]; FM_PIN(sacc); pw2[2] = FM_PKW(P1, 4); FM_PIN(pw2); FM_SBAR(); \
    FM_KR(14, kc_); FM_SBAR(); C1 = __builtin_amdgcn_mfma_f32_32x32x16_f16(kf[11], qr[5], C1, 0, 0, 0); sacc += P1[6]; sacc += P1[7]; FM_PIN(sacc); pw2[3] = FM_PKW(P1, 6); FM_PIN(pw2); FM_SBAR(); \
    FM_KR(15, kc_); FM_QL(8); FM_SBAR(); C0 = __builtin_amdgcn_mfma_f32_32x32x16_f16(kf[12], qr[6], C0, 0, 0, 0); sacc += P1[8]; sacc += P1[9]; FM_PIN(sacc); pw3[0] = FM_PKW(P1, 8); FM_PIN(pw3); FM_SBAR(); \
    FM_KR(16, kc_); FM_SBAR(); C1 = __builtin_amdgcn_mfma_f32_32x32x16_f16(kf[13], qr[6], C1, 0, 0, 0); sacc += P1[10]; sacc += P1[11]; FM_PIN(sacc); pw3[1] = FM_PKW(P1, 10); FM_PIN(pw3); FM_SBAR(); \
    FM_KR(17, kc_); FM_QL(9); FM_SBAR(); C0 = __builtin_amdgcn_mfma_f32_32x32x16_f16(kf[14], qr[7], C0, 0, 0, 0); sacc += P1[12]; sacc += P1[13]; FM_PIN(sacc); pw3[2] = FM_PKW(P1, 12); FM_PIN(pw3); FM_SBAR(); \
    FM_KR(18, kc_); FM_SBAR(); C1 = __builtin_amdgcn_mfma_f32_32x32x16_f16(kf[15], qr[7], C1, 0, 0, 0); sacc += P1[14]; sacc += P1[15]; FM_PIN(sacc); pw3[3] = FM_PKW(P1, 14); FM_PIN(pw3); FM_SBAR(); \
    FM_KR(19, kc_); FM_QL(10); FM_SBAR(); C0 = __builtin_amdgcn_mfma_f32_32x32x16_f16(kf[16], ql[0], C0, 0, 0, 0); FM_SBAR(); \
    FM_KR(20, kc_); FM_SBAR(); C1 = __builtin_amdgcn_mfma_f32_32x32x16_f16(kf[17], ql[0], C1, 0, 0, 0); FM_SBAR(); \
    FM_KR(21, kc_); FM_QL(11); FM_SBAR(); C0 = __builtin_amdgcn_mfma_f32_32x32x16_f16(kf[18], ql[1], C0, 0, 0, 0); FM_SBAR(); \
    FM_KR(22, kc_); FM_SBAR(); C1 = __builtin_amdgcn_mfma_f32_32x32x16_f16(kf[19], ql[1], C1, 0, 0, 0); FM_SBAR(); \
    FM_KR(23, kc_); FM_VRD(0); FM_SBAR(); C0 = __builtin_amdgcn_mfma_f32_32x32x16_f16(kf[20], ql[2], C0, 0, 0, 0); FM_SBAR(); \
    FM_VRD(1); FM_SBAR(); C1 = __builtin_amdgcn_mfma_f32_32x32x16_f16(kf[21], ql[2], C1, 0, 0, 0); FM_SBAR(); \
    FM_VRD(2); FM_SBAR(); C0 = __builtin_amdgcn_mfma_f32_32x32x16_f16(kf[22], ql[3], C0, 0, 0, 0); FM_SBAR(); \
    FM_VRD(3); FM_SBAR(); C1 = __builtin_amdgcn_mfma_f32_32x32x16_f16(kf[23], ql[3], C1, 0, 0, 0); FM_SBAR(); \
    l_reg += sacc; \
    FM_CMASK(C0, C1, t); \
    { float a = FM_MX3(C0[0], C0[1], C1[0]), b = FM_MX3(C0[2], C0[3], C1[1]); a = FM_MX3(a, C1[2], C1[3]); \
      _Pragma("unroll") for (int r = 4; r < 16; r += 4) { a = FM_MX3(a, C0[r], C0[r + 1]); b = FM_MX3(b, C0[r + 2], C0[r + 3]); a = FM_MX3(a, C1[r], C1[r + 1]); b = FM_MX3(b, C1[r + 2], C1[r + 3]); } \
      float rm = __builtin_fmaxf(a, b); { auto rr = __builtin_amdgcn_permlane32_swap(__float_as_uint(rm), __float_as_uint(rm), false, false); rm = __builtin_fmaxf(__uint_as_float(rr[0]), __uint_as_float(rr[1])); } \
      resc = false; \
      if (__builtin_expect(__any(rm > (float)THRL), 0)) { const float dl = __builtin_fmaxf(rm, 0.f); mhat += dl; \
        _Pragma("unroll") for (int r = 0; r < 16; ++r) { C0[r] -= dl; C1[r] -= dl; } \
        _Pragma("unroll") for (int r = 0; r < 16; ++r) negm[r] = -mhat; asm volatile("" : "+v"(negm)); \
        const float f = __builtin_amdgcn_exp2f(-dl); l_reg *= f; if (hi == 0) wsf[r32] = f; resc = true; } } \
    FM_SBAR(); \
    FM_GAPB(FM_PVM(0, 0), C0, 0); FM_VRD(4); FM_SBAR(); \
    FM_GAPB(FM_PVM(1, 0), C0, 2); FM_VRD(5); FM_SBAR(); \
    FM_GAPB(FM_PVM(2, 0), C0, 4); FM_VRD(6); FM_SBAR(); \
    FM_GAPB(FM_PVM(3, 0), C0, 6); FM_VRD(7); FM_SBAR(); \
    FM_GAPB(FM_PVM(4, 1), C0, 8); FM_VRD(8); FM_SBAR(); \
    FM_GAPB(FM_PVM(5, 1), C0, 10); FM_VRD(9); FM_SBAR(); \
    FM_GAPB(FM_PVM(6, 1), C0, 12); FM_VRD(10); FM_SBAR(); \
    FM_GAPB(FM_PVM(7, 1), C0, 14); FM_VRD(11); FM_SBAR(); \
    FM_GAPB(FM_PVM(8, 2), C1, 0); FM_VRD(12); FM_SBAR(); \
    FM_GAPB(FM_PVM(9, 2), C1, 2); FM_VRD(13); FM_SBAR(); \
    FM_GAPB(FM_PVM(10, 2), C1, 4); FM_VRD(14); FM_SBAR(); \
    FM_GAPB(FM_PVM(11, 2), C1, 6); FM_VRD(15); FM_SBAR(); \
    if (GL) { FM_KR(0, FM_KO(sl_next)); FM_KR(1, FM_KO(sl_next)); FM_SBAR(); } FM_GAPB(FM_PVM(12, 3), C1, 8); \
    if (GL) { FM_KR(2, FM_KO(sl_next)); FM_SBAR(); } FM_GAPB(FM_PVM(13, 3), C1, 10); \
    FM_GAPB(FM_PVM(14, 3), C1, 12); \
    FM_GAPB(FM_PVM(15, 3), C1, 14); \
    } while (0)
    int t = 1;
#undef FM_CMASK
#define FM_CMASK(P0, P1, t) do { } while (0)
    for (; t + 5 < NT; t += 2) {
        FM_STEP(pB0, pB1, pA0, pA1, t, true, true, true);     FM_WAIT_BAR(0); FM_RESC(); FM_ROT();
        FM_STEP(pA0, pA1, pB0, pB1, t + 1, true, true, true); FM_WAIT_BAR(0); FM_RESC(); FM_ROT();
    }
#undef FM_CMASK
#define FM_CMASK(P0, P1, t) do { const int jb_ = (t) - (NT - 4); if (jb_ >= 0) { const int k0_ = 64 * jb_, w0_ = wid * 32;     \
        if (k0_ + 63 > w0_) { if (k0_ > w0_ + 31) { _Pragma("unroll") for (int r_ = 0; r_ < 16; ++r_) { P0[r_] = -INFINITY; P1[r_] = -INFINITY; } } else fa::cmask(P0, P1, k0_, qrel, hi); } } } while (0)
    for (; t + 1 < NT; t += 2) {
        FM_STEP(pB0, pB1, pA0, pA1, t, (t + 2 < NT), (t + 1 < NT), (t + 1 < NT));         FM_WAIT_BAR(0); FM_RESC(); FM_ROT();
        FM_STEP(pA0, pA1, pB0, pB1, t + 1, (t + 3 < NT), (t + 2 < NT), (t + 2 < NT));     FM_WAIT_BAR(0); FM_RESC(); FM_ROT();
    }
    FM_STEP(pB0, pB1, pA0, pA1, NT - 1, false, false, false); FM_RESC();
    { float sacc = pB0[0] + pB0[1];
#pragma unroll
      for (int r = 2; r < 16; ++r) sacc += pB0[r];
#pragma unroll
      for (int r = 0; r < 16; ++r) sacc += pB1[r];
      l_reg += sacc;
      pw0 = (u32x4){FM_PKW(pB0, 0), FM_PKW(pB0, 2), FM_PKW(pB0, 4), FM_PKW(pB0, 6)}; pw1 = (u32x4){FM_PKW(pB0, 8), FM_PKW(pB0, 10), FM_PKW(pB0, 12), FM_PKW(pB0, 14)};
      pw2 = (u32x4){FM_PKW(pB1, 0), FM_PKW(pB1, 2), FM_PKW(pB1, 4), FM_PKW(pB1, 6)}; pw3 = (u32x4){FM_PKW(pB1, 8), FM_PKW(pB1, 10), FM_PKW(pB1, 12), FM_PKW(pB1, 14)};
      FM_SBAR(); fd::pv(o, vb0 + sl_cur, FM_PAF(0), FM_PAF(1), FM_PAF(2), FM_PAF(3)); }
    { auto rr = __builtin_amdgcn_permlane32_swap(__float_as_uint(l_reg), __float_as_uint(l_reg), false, false); l_reg = __uint_as_float(rr[0]) + __uint_as_float(rr[1]); }
    if (hi == 0) wsf[32 + r32] = l_reg; asm volatile("s_waitcnt lgkmcnt(0)" ::: "memory");
    float rli[16];
#pragma unroll
    for (int r = 0; r < 16; ++r) rli[r] = __builtin_amdgcn_rcpf(wsf[32 + crow(r, hi)]);
    asm volatile("s_waitcnt lgkmcnt(0)\n\ts_barrier" ::: "memory");
    char* stg = shm + wid * (32 * 272);
#pragma unroll
    for (int r = 0; r < 16; ++r) { const int orow = crow(r, hi);
#pragma unroll
        for (int d0 = 0; d0 < 4; ++d0) *(h16*)(stg + orow * 272 + (d0 * 32 + r32) * 2) = (h16)(o[d0][r] * rli[r]); }
    asm volatile("s_waitcnt lgkmcnt(0)" ::: "memory");
    { h16* Ow = (h16*)(fd::ptab_abs(34) + WS_MIX) + (size_t)(t0 + q0 + wid * 32) * 1024 + 512 + h * 128; const int ch = lane & 15;
      const f32x8 g8v = *(const f32x8*)((const float*)fd::ptab_abs(13) + ch * 8);
#pragma unroll
      for (int i = 0; i < 8; ++i) { const int row = i * 4 + (lane >> 4);
          const h16x8 a = *(const h16x8*)(stg + row * 272 + ch * 16); float v[8];
#pragma unroll
          for (int e = 0; e < 8; ++e) v[e] = (float)a[e];
          float ss = 0.f;
#pragma unroll
          for (int e = 0; e < 8; ++e) ss += v[e] * v[e];
          ss += shx(ss, 1); ss += shx(ss, 2); ss += shx(ss, 4); ss += shx(ss, 8);
          const float rs = rsqrtf(ss * (1.f / 128.f) + RMS_EPS); h16x8 ov;
#pragma unroll
          for (int e = 0; e < 8; ++e) ov[e] = (h16)(v[e] * rs * g8v[e]);
          *(h16x8*)(Ow + (size_t)row * 1024 + ch * 8) = ov; } }
    asm volatile("s_waitcnt lgkmcnt(0)\n\ts_barrier" ::: "memory");
#undef FM_DMA_K
#undef FM_DMA_V
#undef FM_CMASK
#undef FM_RESC
#undef FM_ROT
#undef FM_KO
#undef FM_PKW
#undef FM_PAF
#undef FM_VFR
#undef FM_PIN
#undef FM_MX3
#undef FM_EX
#undef FM_GAPB
#undef FM_VRD
#undef FM_KR
#undef FM_QL
#undef FM_PVM
#undef FM_STEP
}
#undef FM_SBAR
#undef FM_WAIT_BAR
}
__device__ __forceinline__ void ph_attn_mla(char* lds, const h16* __restrict__ PROJp, const h16* __restrict__ QKVMp, h16* __restrict__ MIXp, int* __restrict__ qctr, const float* __restrict__ gm, const float* __restrict__ ropem) {
#pragma unroll 1
    for (int it = 0; ; ++it) {
        const int w = bid_fresh() + (it >> 1) * gdx(); if (w >= 256) break;
        const int qb = it ? (w >> 5) : 15 - (w >> 5), b = (w & 31) >> 2, h = w & 3; const int q0 = qb * 256; const size_t t0 = (size_t)b * SEQ;
        fm::attn_unit<8>((int)t0, h, q0, lds);
    }
}
__device__ __forceinline__ void ph_attn_diff(char* lds, const h16* __restrict__ PROJp, h16* __restrict__ MIXp, int* __restrict__ qctr, const float* __restrict__ roped, const float* __restrict__ gd,
                                             const float* __restrict__ lq1, const float* __restrict__ lk1, const float* __restrict__ lq2, const float* __restrict__ lk2) {
    const int lane = tid_fresh() & 63;
    const float lamv = __expf(wave_sum(lq1[lane] * lk1[lane])) - __expf(wave_sum(lq2[lane] * lk2[lane])) + 0.2f;
    const float lam = __builtin_bit_cast(float, __builtin_amdgcn_readfirstlane(__builtin_bit_cast(int, lamv)));
#pragma unroll 1
    for (int it = 0; ; ++it) {
        const int w = bid_fresh() + (it >> 1) * gdx(); if (w >= 256) break;
        const int qb = it ? (w >> 5) : 15 - (w >> 5), b = (w & 31) >> 2, h = w & 3; const int q0 = qb * 256; const size_t t0 = (size_t)b * SEQ;
        for (int mi = 0; mi < 2; ++mi) { const int m = 2 * h + mi;
            fd::attn_unit<8>((int)((t0 + q0) * NPROJ) + m * 64, (int)(t0 * NPROJ) + C_DK + m * 64, (int)(t0 * NPROJ) + C_DV + h * 128, (int)((t0 + q0) * 1024) + h * 128, (int)(t0 + q0), q0, lds, mi, lam); }
    }
}
__device__ __forceinline__ void ph_attn_cross(char* lds, const h16* __restrict__ QXp, const h16* __restrict__ MKVp, h16* __restrict__ OXp, const g8::DenseOrder& S) {
    g8::Unit u;
    for (int i = 0; S.next(i, u); ++i) {
        const int b = u.pm >> 4; const size_t t0 = (size_t)u.pm * 256;
        for (int hh = 0; hh < 2; ++hh) { const int h = 2 * u.pn + hh;
            fa::attn_unit<2>(QXp + t0 * 512 + h * 128, 512, MKVp + (size_t)b * NMEM * 1024 + h * 128, 1024, nullptr, 0, MKVp + (size_t)b * NMEM * 1024 + 512 + h * 128, 1024,
                             OXp + t0 * 512 + h * 128, 512, NMEM, 1 << 28, lds, 0, nullptr, 0.f, nullptr); }
    }
}

__global__ void __launch_bounds__(NTHR, 2) mega(Params p) {
    extern __shared__ __attribute__((aligned(16))) char smem[];
    if (threadIdx.x < 35) ((unsigned long long*)(smem + LDS_PTAB))[threadIdx.x] = ((const unsigned long long*)__builtin_amdgcn_kernarg_segment_ptr())[threadIdx.x];
    if (threadIdx.x == 0) *(uint4*)(smem + LDS_XB) = make_uint4(0u, 0u, 0u, 0u);
    if (threadIdx.x == 0) *(int*)(smem + LDS_GDX) = (int)gridDim.x;
    if ((threadIdx.x & 63) == 0) ((int*)(smem + LDS_WTAB))[hw_slot()] = (int)(threadIdx.x >> 6);
    static_assert(LDS_GDX == LDS_BYTES - 32, "LDS_GDX");
    __syncthreads();
#define PTAB(i) ({ const unsigned* _t = (const unsigned*)(smem + LDS_PTAB) + 2 * (i); const unsigned _lo = __builtin_amdgcn_readfirstlane(_t[0]), _hi = __builtin_amdgcn_readfirstlane(_t[1]); \
                   (char*)(__attribute__((address_space(1))) char*)(((unsigned long long)_hi << 32) | (unsigned long long)_lo); })
    (void)xcd_barrier_post((unsigned*)(PTAB(34) + WS_BAR), (volatile LAS unsigned*)(smem + LDS_XB));
#define GRID_BAR() do { XcdBarrier _b; _b.bar = (unsigned*)(PTAB(34) + WS_BAR); _b.x = xb_xcc_id(); _b.st = (volatile LAS unsigned*)(smem + LDS_XB); xcd_barrier(_b); } while (0)
#define WSF() PTAB(34)
#define FIN(i) ((const float*)PTAB(i))
#define XIN ((const float*)FIN(0))
#define POSIN ((const int*)PTAB(2))
#define ctl ((int*)(WSF() + WS_CTL))
#define WinT ((h16*)(WSF() + WS_WIN))
#define WupT ((h16*)(WSF() + WS_WUP))
#define WoT ((h16*)(WSF() + WS_WO))
#define WmqT ((h16*)(WSF() + WS_WMQ))
#define WmkvT ((h16*)(WSF() + WS_WMKV))
#define WmoT ((h16*)(WSF() + WS_WMO))
#define WguT ((h16*)(WSF() + WS_WGU))
#define WdT ((h16*)(WSF() + WS_WD))
#define Xh ((h16*)(WSF() + WS_XH))
#define MEMh ((h16*)(WSF() + WS_MEMH))
#define MKV ((h16*)(WSF() + WS_MKV))
#define PROJ ((h16*)(WSF() + WS_PROJ))
#define QKVM ((h16*)(WSF() + WS_QKVM))
#define MIX ((h16*)(WSF() + WS_MIX))
#define H2h ((h16*)(WSF() + WS_H2H))
#define H1h ((h16*)(WSF() + WS_H1H))
#define QX ((h16*)(WSF() + WS_QX))
#define STAT ((f32x2*)(WSF() + WS_PROJ))
#define MURS ((f32x2*)(WSF() + WS_PROJ + 4 * MiB))
#define CSBW ((float*)(WSF() + WS_RW + 512 * 1024))
#define OX ((h16*)(WSF() + WS_OX))
#define Hs ((h16*)(WSF() + WS_HS))
#define HsS ((h16*)(WSF() + WS_HSS))
#define Ssh ((h16*)(WSF() + WS_SSH))
#define Y ((h16*)(WSF() + WS_Y))
#define rope ((float*)(WSF() + WS_ROPE))
#define RWh ((h16*)(WSF() + WS_RW))
#define RWl ((h16*)(WSF() + WS_RW + 128 * 1024))
#define Y1 ((float*)(WSF() + WS_Y1))
#define H2 ((float*)PTAB(33))
#define topi ((int*)(WSF() + WS_TOP))
#define topw ((float*)(WSF() + WS_TOP + 1 * MiB))
#define rowtok ((int*)(WSF() + WS_LIST))
#define rowdst (rowtok + NCHUNK * ROWS_CH)
#define roww ((float*)(rowdst + NCHUNK * ROWS_CH))
    float* tile = (float*)smem;
    LAS unsigned char* ldsg = (LAS unsigned char*)smem;
    LAS int* t2e = (LAS int*)(smem + 131072);
    ph_cvt(XIN, Xh, (long)T * DM / 8);
    ph_cvt(FIN(1), MEMh, (long)TM * DM / 8);
    ph_tcvt<4>(tile, FIN(3), 1024, 1984, 1, WinT, 1024, 0, 0, 0L);
    ph_tcvt<0>(tile, FIN(10), 256, 768, 1, WupT, KUP, 0, 0, 0L);
    ph_tcvt<0>(tile, FIN(12), 128, 1024, 1, WupT, KUP, 256, 768, 0L);
    ph_tcvt<0>(tile, FIN(14), 1024, 1024, 1, WoT, 1024, 0, 0, 0L);
    ph_tcvt<0, 4, 0, 0, true>(tile, FIN(17), 1024, 512, 1, WmqT, 1024, 0, 0, 0L, 0, -1, -2, 0, FIN(15));
    ph_tcvt<0>(tile, FIN(18), 1024, 512, 1, WmkvT, 1024, 0, 0, 0L);
    ph_tcvt<0>(tile, FIN(19), 1024, 512, 1, WmkvT, 1024, 0, 512, 0L);
    ph_tcvt<0>(tile, FIN(20), 512, 1024, 1, WmoT, 512, 0, 0, 0L);
    ph_rope_tables(POSIN, rope, smem + 80 * 1024);
    {
        const float* rwf = FIN(23); h16* rh = RWh; h16* rl = RWl;
        for (int i = bid_fresh() * NTHR + tid_fresh(); i < DM * NE; i += gdx() * NTHR) { const int k = i >> 6, e = i & 63; const float w = rwf[i] * 1024.f; const h16 hi = (h16)w; rh[(size_t)e * DM + k] = hi; rl[(size_t)e * DM + k] = (h16)(w - (float)hi); }
    }
    {
        const int tid = tid_fresh(); typedef unsigned u32x4_ __attribute__((ext_vector_type(4))); const u32x4_ z = {0u, 0u, 0u, 0u};
        for (int i = bid_fresh() * NTHR + tid; i < 64 * 1024 / 8; i += gdx() * NTHR) *(u32x4_*)(WinT + (size_t)1984 * 1024 + (size_t)i * 8) = z;
        for (int i = bid_fresh() * NTHR + tid; i < 768 * 16; i += gdx() * NTHR) *(u32x4_*)(WupT + (size_t)(i >> 4) * KUP + 256 + (i & 15) * 8) = z;
        for (int i = bid_fresh() * NTHR + tid; i < 1024 * 32; i += gdx() * NTHR) *(u32x4_*)(WupT + (size_t)(768 + (i >> 5)) * KUP + (i & 31) * 8) = z;
    }
    ph_list_init(rowtok, rowdst, roww);
    GRID_BAR();
    { g8::DenseOrder S; S.init(Xh, 1024, WinT, 1024, T, NPROJ); g8::gemm_phase<g8::EpiH, g8::DenseOrder, false, true>(ldsg, 1024, 1024, 1024, S, g8::EpiH{PROJ, NPROJ}); }
    GRID_BAR();
    { const int g_ = gdx(), b_ = bid_fresh(); const bool sp_ = g_ >= 64;
      if (!sp_ || b_ < 32) { g8::DenseOrder S; S.init(MEMh, 1024, WmkvT, 1024, TM, 1024); g8::gemm_phase<g8::EpiH, g8::DenseOrder, false, true>(ldsg, 1024, 1024, 1024, S, g8::EpiH{MKV, 1024}); }
      ph_postproj(PROJ, rope, FIN(9), FIN(11), sp_ ? b_ - 32 : b_, sp_ ? g_ - 32 : g_); }
    ph_lnfold(WmqT, FIN(17), FIN(16), CSBW);
    GRID_BAR();
    { g8::DenseOrder S; S.init(PROJ + C_CQ, NPROJ, WupT, KUP, T, NUP); g8::gemm_phase<g8::EpiH, g8::DenseOrder, false, true>(ldsg, KUP, NPROJ, KUP, S, g8::EpiH{QKVM, NUP}); }
    if (gdx() == 256) { const int b_ = bid_fresh();
        ph_tcvt<1, 8, 1024, 256>(tile, FIN(25), 1024, 256, 64, WguT, 1024, 0, 0, (long)512 * 1024, b_ >= 128 ? 0 : 3136, b_ >= 128 ? 3136 : 4096, b_ >= 128 ? b_ - 128 : b_, 128); }
    GRID_BAR();
    const int gate0_ = gdx() == 256 ? 4096 : 0;
#define EXPERT_CVT() do { \
        ph_tcvt<1, 8, 1024, 256>(tile, FIN(25), 1024, 256, 64, WguT, 1024, 0, 0, (long)512 * 1024, gate0_, 4096, (int)bid_fresh(), (int)gdx()); \
        ph_tcvt<2, 8, 1024, 256>(tile, FIN(26), 1024, 256, 64, WguT, 1024, 0, 0, (long)512 * 1024); \
        ph_tcvt<3, 8, 256, 1024>(tile, FIN(27), 256, 1024, 64, WdT, 256, 0, 0, (long)1024 * 256); \
        ph_tcvt<1, 8, 1024, 256>(tile, FIN(28), 1024, 256, 1, WguT + (size_t)64 * 512 * 1024, 1024, 0, 0, 0L); \
        ph_tcvt<2, 8, 1024, 256>(tile, FIN(29), 1024, 256, 1, WguT + (size_t)64 * 512 * 1024, 1024, 0, 0, 0L); \
        ph_tcvt<0, 8, 256, 1024>(tile, FIN(30), 256, 1024, 1, WdT + (size_t)64 * 1024 * 256, 256, 0, 0, 0L); \
    } while (0)
    if ((bid_fresh() & 1) == 0) EXPERT_CVT();
    ph_attn_mla(smem, PROJ, QKVM, MIX, ctl + CW_AQ, FIN(13), rope + (size_t)T * 16);
    ph_attn_diff(smem, PROJ, MIX, ctl + CW_AQ + 64, rope, FIN(8), FIN(4), FIN(5), FIN(6), FIN(7));
    if ((bid_fresh() & 1) != 0) EXPERT_CVT();
    GRID_BAR();
    { g8::DenseOrder S; S.init(MIX, 1024, WoT, 1024, T, DM); g8::gemm_phase<g8::EpiResStat, g8::DenseOrder, false, true>(ldsg, 1024, 1024, 1024, S, g8::EpiResStat{Xh, H1h, STAT}); }
    GRID_BAR();
    { g8::DenseOrder S; S.init(H1h, 1024, WmqT, 1024, T, 512); ph_murs(S, STAT, MURS); g8::gemm_phase<g8::EpiLnQ, g8::DenseOrder, false, true>(ldsg, 1024, 1024, 1024, S, g8::EpiLnQ{QX, 512, MURS, CSBW});
      asm volatile("s_waitcnt vmcnt(0)" ::: "memory"); __syncthreads();
      ph_attn_cross(smem, QX, MKV, OX, S); }
    GRID_BAR();
    { g8::DenseOrder S; S.init(OX, 512, WmoT, 512, T, DM); g8::gemm_phase<g8::EpiResLn, g8::DenseOrder, false, true>(ldsg, 512, 512, 512, S, g8::EpiResLn{H1h, H2h, MURS, FIN(15), FIN(16)}); }
    GRID_BAR();
    ph_router(smem, H2h, FIN(21), FIN(22), RWh, RWl, FIN(24), topi, topw, ctl);
    GRID_BAR();
    { int* loff = (int*)smem; ph_offsets(loff, ctl); ph_fill(loff, topi, topw, ctl, rowtok, rowdst, roww); __syncthreads(); }
    { g8::DenseOrder S; S.init(H2h, 1024, WguT + (size_t)64 * 512 * 1024, 1024, T, 512); g8::gemm_phase<g8::EpiGU, g8::DenseOrder, false, true>(ldsg, 1024, 1024, 1024, S, g8::EpiGU{HsS, nullptr}); }
    GRID_BAR();
    { g8::DenseLight S; S.init(HsS, EDIM, WdT + (size_t)64 * 1024 * 256, EDIM, T, DM); S.init_light((2 * ((ctl + CW_OFF)[NE] >> 8)) % (int)gdx(), 4);
      g8::gemm_phase<g8::EpiRes<1>, g8::DenseLight, false, true>(ldsg, EDIM, EDIM, EDIM, S, g8::EpiRes<1>{nullptr, H2h, Ssh, nullptr}); }
#define MOE_GU(c) do { \
        const int ntile = ph_tile_map(t2e, ctl + CW_OFF + c * 66); \
        g8::GroupOrder S{(const char*)H2h, (const char*)WguT, rowtok + (size_t)c * ROWS_CH, t2e, (long)512 * 1024, 1024, 1024, ntile, 2, (int)gdx(), (int)bid_fresh(), true}; \
        g8::gemm_phase<g8::EpiGU, g8::GroupOrder, true, true>(ldsg, 1024, 1024, 1024, S, g8::EpiGU{Hs, roww + (size_t)c * ROWS_CH}); \
    } while (0)
#define MOE_DN(c) do { \
        const int ntile = (ctl + CW_OFF + c * 66)[NE] >> 8; \
        g8::GroupOrder S{(const char*)Hs, (const char*)WdT, rowtok + (size_t)c * ROWS_CH, t2e, (long)1024 * 256, EDIM, EDIM, ntile, 4, (int)gdx(), (int)bid_fresh(), false}; \
        g8::gemm_phase<g8::EpiDn, g8::GroupOrder, false, true>(ldsg, EDIM, EDIM, EDIM, S, g8::EpiDn{(unsigned char*)Y, rowdst + (size_t)c * ROWS_CH}); \
    } while (0)
#define MOE_CB(c, r) do { int tb_, tn_; cb_range(r, tb_, tn_); ph_combine((const unsigned char*)Y, Ssh, H2, c * TCH, FIN(31), FIN(32), tb_, tn_); } while (0)
    MOE_GU(0); GRID_BAR(); MOE_DN(0); GRID_BAR();
    MOE_GU(1); MOE_CB(0, (2 * ((ctl + CW_OFF + 66)[NE] >> 8)) % (int)gdx()); GRID_BAR(); MOE_DN(1); GRID_BAR();
    MOE_CB(1, 0);
    static_assert(NCHUNK == 2, "MoE phase program");
}

extern "C" void kernel_launch(void* const* d_in, const int* in_sizes, int n_in, void* d_out, int out_size, void* d_ws, size_t ws_size, hipStream_t stream) {
    if (n_in != 33 || ws_size < WS_END || out_size != T * DM) { fprintf(stderr, "kernel_launch: bad args n_in %d ws %zu out %d\n", n_in, ws_size, out_size); return; }
    static int grid = 0;
    if (!grid) {
        int dev = 0, cus = 0, per_cu = 0;
        (void)hipGetDevice(&dev); (void)hipDeviceGetAttribute(&cus, hipDeviceAttributeMultiprocessorCount, dev);
        if (hipFuncSetAttribute((const void*)mega, hipFuncAttributeMaxDynamicSharedMemorySize, LDS_BYTES) != hipSuccess) { fprintf(stderr, "kernel_launch: hipFuncSetAttribute failed\n"); return; }
        (void)hipOccupancyMaxActiveBlocksPerMultiprocessor(&per_cu, (const void*)mega, NTHR, LDS_BYTES);
        if (per_cu < 1 || cus < 1) { fprintf(stderr, "kernel_launch: occupancy %d cus %d\n", per_cu, cus); return; }
        grid = cus;
    }
    char* ws = (char*)d_ws;
    (void)hipMemsetAsync(ws + WS_CTL, 0, 128 * 1024, stream);
    Params p{};
    for (int i = 0; i < 33; ++i) p.in[i] = (const float*)d_in[i];
    p.out = (float*)d_out; p.ws = ws;
    hipLaunchKernelGGL(mega, dim3(grid), dim3(NTHR), LDS_BYTES, stream, p);
}
```
